# Optimizing an MI355X kernel written in HIP

```python
import jax, jax.numpy as jnp
from jax import lax
import numpy as np

D_MODEL = 2048
BATCH = 2
SEQ = 4096
DEPTH = 2

CHUNK = 64
EPS = 1e-6
N_EVEN = (DEPTH + 1) // 2
N_ODD = DEPTH // 2

GMLP_BLOCK = 128
A_HEADS = 8
A_HEAD_DIM = D_MODEL // 2 // A_HEADS
D_A = A_HEADS * A_HEAD_DIM

POOL_WINDOWS = (2, 4, 8, 16)
B_GROUPS = len(POOL_WINDOWS)
B_GROUP_DIM = D_MODEL // 2 // B_GROUPS
D_B = B_GROUPS * B_GROUP_DIM

C_HEADS = 16
Q_LORA = 512
KV_LORA = 512
NOPE_DIM = 128
ROPE_DIM = 64
V_DIM = 128
ROPE_THETA = 10000.0
Q_BLOCK = 128

D_FF = -(-8 * D_MODEL // (3 * 256)) * 256

kernel_name = "hybrid_gmlp_pool_mla_stream_trunk"


def rmsnorm(x, g):
    xf = x.astype(jnp.float32)
    y = xf * lax.rsqrt(jnp.mean(xf * xf, axis=-1, keepdims=True) + EPS)
    return (y * g.astype(jnp.float32)).astype(x.dtype)


def apply_rope(x, cos, sin):
    xf = x.astype(jnp.float32)
    half = x.shape[-1] // 2
    x1, x2 = xf[..., :half], xf[..., half:]
    return jnp.concatenate([x1 * cos - x2 * sin, x2 * cos + x1 * sin], axis=-1).astype(x.dtype)


def gmlp_mixer(uv, g_v, w_s, b_s):
    B_, S_, _ = uv.shape
    uv = jax.nn.gelu(uv)
    u, v = uv[..., :D_A], uv[..., D_A:]
    v = rmsnorm(v, g_v)
    nb = S_ // GMLP_BLOCK
    v = v.reshape(B_, nb, GMLP_BLOCK, A_HEADS, A_HEAD_DIM)
    pos_chunk = jnp.arange(GMLP_BLOCK) // CHUNK
    mask = (pos_chunk[None, :] <= pos_chunk[:, None]).astype(w_s.dtype)
    w = w_s * mask[None]
    mix = jnp.einsum('hts,bnshd->bnthd', w, v) + jnp.swapaxes(b_s, 0, 1)[None, None, :, :, None]
    return u * mix.reshape(B_, S_, D_A)


def multi_scale_pool(z, w_pool, scale):
    B_, S_, _ = z.shape
    zg = z.reshape(B_, S_, B_GROUPS, B_GROUP_DIM)
    cs = jnp.cumsum(zg.astype(jnp.float32), axis=1)
    cs = jnp.pad(cs, ((0, 0), (1, 0), (0, 0), (0, 0)))
    t1 = jnp.arange(1, S_ + 1)
    outs = []
    for g, win in enumerate(POOL_WINDOWS):
        c = cs[:, :, g]
        lo = jnp.pad(c, ((0, 0), (win - 1, 0), (0, 0)))[:, :S_]
        cnt = jnp.minimum(t1, win).astype(jnp.float32)[None, :, None]
        outs.append((c[:, 1:] - lo) / cnt)
    pooled = jnp.stack(outs, axis=2)
    d = (pooled - zg.astype(jnp.float32)).astype(z.dtype)
    y = jnp.einsum('bsgc,gcd->bsgd', d, w_pool).reshape(B_, S_, D_B)
    return y * scale


def mla(h, w_in_c, g_cq, g_ckv, w_uq, w_ukv, w_out_c, cos, sin):
    B_, S_, _ = h.shape
    p = h @ w_in_c
    c_q = p[..., :Q_LORA]
    c_kv = p[..., Q_LORA:Q_LORA + KV_LORA]
    k_rope = apply_rope(p[..., Q_LORA + KV_LORA:], cos, sin)
    q = (rmsnorm(c_q, g_cq) @ w_uq).reshape(B_, S_, C_HEADS, NOPE_DIM + ROPE_DIM)
    q_nope = q[..., :NOPE_DIM]
    q_rope = apply_rope(q[..., NOPE_DIM:], cos[:, None, :], sin[:, None, :])
    kv = (rmsnorm(c_kv, g_ckv) @ w_ukv).reshape(B_, S_, C_HEADS, NOPE_DIM + V_DIM)
    k_nope, v = kv[..., :NOPE_DIM], kv[..., NOPE_DIM:]
    nq = S_ // Q_BLOCK
    key_chunk = jnp.arange(S_) // CHUNK
    sm_scale = (NOPE_DIM + ROPE_DIM) ** -0.5

    def to_blocks(t):
        return jnp.moveaxis(t.reshape(B_, nq, Q_BLOCK, *t.shape[2:]), 1, 0)

    def attend(args):
        qn, qr, blk = args
        s = (jnp.einsum('bqhd,bkhd->bhqk', qn, k_nope)
             + jnp.einsum('bqhr,bkr->bhqk', qr, k_rope)).astype(jnp.float32) * sm_scale
        q_chunk = (blk * Q_BLOCK + jnp.arange(Q_BLOCK)) // CHUNK
        mask = key_chunk[None, :] <= q_chunk[:, None]
        s = jnp.where(mask[None, None], s, -jnp.inf)
        pr = jax.nn.softmax(s, axis=-1).astype(v.dtype)
        return jnp.einsum('bhqk,bkhd->bqhd', pr, v)

    o = lax.map(attend, (to_blocks(q_nope), to_blocks(q_rope), jnp.arange(nq)))
    o = jnp.moveaxis(o, 0, 1).reshape(B_, S_, C_HEADS * V_DIM)
    return o @ w_out_c


def swiglu(h, w_gate, w_up, w_down):
    return (jax.nn.silu(h @ w_gate) * (h @ w_up)) @ w_down


def setup_inputs(seed: int = 0) -> dict:
    key = jax.random.key(seed)
    ks = jax.random.split(key, 24)
    f32 = jnp.float32

    def w(k, shape, fan_in):
        return jax.random.normal(k, shape, f32) * (fan_in ** -0.5)

    def gain(k, shape):
        return 1.0 + 0.05 * jax.random.normal(k, shape, f32)

    return {
        'x': jax.random.normal(ks[0], (BATCH, SEQ, D_MODEL), f32),
        'g_mix': gain(ks[1], (DEPTH, D_MODEL)),
        'g_ffn': gain(ks[2], (DEPTH, D_MODEL)),
        'g_final': gain(ks[3], (D_MODEL,)),
        'w_in_ab': w(ks[4], (N_EVEN, D_MODEL, 2 * D_A + D_B), D_MODEL),
        'g_v': gain(ks[5], (N_EVEN, D_A)),
        'w_s': w(ks[6], (N_EVEN, A_HEADS, GMLP_BLOCK, GMLP_BLOCK), GMLP_BLOCK),
        'b_s': 1.0 + 0.1 * jax.random.normal(ks[7], (N_EVEN, A_HEADS, GMLP_BLOCK), f32),
        'w_pool': w(ks[8], (N_EVEN, B_GROUPS, B_GROUP_DIM, B_GROUP_DIM), B_GROUP_DIM),
        'pool_scale': 1.0 + 0.1 * jax.random.normal(ks[9], (N_EVEN, D_B), f32),
        'w_out_ab': w(ks[10], (N_EVEN, D_A + D_B, D_MODEL), D_A + D_B),
        'w_in_c': w(ks[11], (N_ODD, D_MODEL, Q_LORA + KV_LORA + ROPE_DIM), D_MODEL),
        'g_cq': gain(ks[12], (N_ODD, Q_LORA)),
        'g_ckv': gain(ks[13], (N_ODD, KV_LORA)),
        'w_uq': w(ks[14], (N_ODD, Q_LORA, C_HEADS * (NOPE_DIM + ROPE_DIM)), Q_LORA),
        'w_ukv': w(ks[15], (N_ODD, KV_LORA, C_HEADS * (NOPE_DIM + V_DIM)), KV_LORA),
        'w_out_c': w(ks[16], (N_ODD, C_HEADS * V_DIM, D_MODEL), C_HEADS * V_DIM),
        'w_gate': w(ks[17], (DEPTH, D_MODEL, D_FF), D_MODEL),
        'w_up': w(ks[18], (DEPTH, D_MODEL, D_FF), D_MODEL),
        'w_down': w(ks[19], (DEPTH, D_FF, D_MODEL), D_FF),
    }


def reference(x, g_mix, g_ffn, g_final, w_in_ab, g_v, w_s, b_s, w_pool, pool_scale, w_out_ab,
              w_in_c, g_cq, g_ckv, w_uq, w_ukv, w_out_c, w_gate, w_up, w_down):
    S_ = x.shape[1]
    pos = jnp.arange(S_, dtype=jnp.float32)
    inv_freq = ROPE_THETA ** (-jnp.arange(0, ROPE_DIM, 2, dtype=jnp.float32) / ROPE_DIM)
    ang = pos[:, None] * inv_freq[None, :]
    cos, sin = jnp.cos(ang), jnp.sin(ang)
    for layer in range(DEPTH):
        i = layer // 2
        h = rmsnorm(x, g_mix[layer])
        if layer % 2 == 0:
            p = h @ w_in_ab[i]
            a = gmlp_mixer(p[..., :2 * D_A], g_v[i], w_s[i], b_s[i])
            b = multi_scale_pool(p[..., 2 * D_A:], w_pool[i], pool_scale[i])
            mix = jnp.concatenate([a, b], axis=-1) @ w_out_ab[i]
        else:
            mix = mla(h, w_in_c[i], g_cq[i], g_ckv[i], w_uq[i], w_ukv[i], w_out_c[i], cos, sin)
        x = x + mix
        x = x + swiglu(rmsnorm(x, g_ffn[layer]), w_gate[layer], w_up[layer], w_down[layer])
    return rmsnorm(x, g_final)
```

```cpp
#include <hip/hip_runtime.h>
#include <hip/hip_cooperative_groups.h>
#include <cstdio>
namespace cg = cooperative_groups;

#ifndef MEGA
#define MEGA 1
#endif
#ifndef PROBE_FULL
#define PROBE_FULL 0
#endif
#ifndef PROBE_BAR
#define PROBE_BAR 0
#endif
#ifndef PROBE_PH
#define PROBE_PH (-1)
#endif

#define LAS __attribute__((address_space(3)))
#define DI __device__ __forceinline__
typedef unsigned short bf16_t;
typedef short bf16x8 __attribute__((ext_vector_type(8)));
typedef float f32x4 __attribute__((ext_vector_type(4)));
typedef float f32x2 __attribute__((ext_vector_type(2)));
typedef float f32x16 __attribute__((ext_vector_type(16)));
typedef unsigned u32x4 __attribute__((ext_vector_type(4)));
typedef unsigned u32x2 __attribute__((ext_vector_type(2)));
typedef __bf16 bf16v2 __attribute__((ext_vector_type(2)));

DI unsigned pk2(float a, float b) { f32x2 f = {a, b}; bf16v2 r = __builtin_convertvector(f, bf16v2); return __builtin_bit_cast(unsigned, r); }
DI u32x2 pk4(f32x4 v) { u32x2 r; r.x = pk2(v[0], v[1]); r.y = pk2(v[2], v[3]); return r; }
DI float bf_lo(unsigned w) { return __uint_as_float(w << 16); }
DI float bf_hi(unsigned w) { return __uint_as_float(w & 0xffff0000u); }
DI float gelu_tanh(float x) { const float t = x * (1.5957691216f + 0.0713548163f * x * x); return x * __builtin_amdgcn_rcpf(1.f + __builtin_amdgcn_exp2f(-1.4426950409f * t)); }
DI float silu_f(float x) { return x * __builtin_amdgcn_rcpf(1.f + __builtin_amdgcn_exp2f(-1.4426950409f * x)); }
DI float rstd_of(float ssq, float inv_n) { return __builtin_amdgcn_rsqf(ssq * inv_n + 1e-6f); }

constexpr int MT = 8192, SEQ = 4096, DM = 2048, DFF = 5632;
constexpr int NTHR = 512, LDS_MAIN = 131072, LDS_BYTES = LDS_MAIN + 64;
constexpr int NPH = 14;
constexpr float QSCALE = 0.07216878364870322f * 1.4426950408889634f;

constexpr size_t MiB = 1048576;
constexpr size_t OFF_W1UZ = 0 * MiB, OFF_W1V = 8 * MiB, OFF_WOAB = 12 * MiB, OFF_WGU0 = 20 * MiB, OFF_WD0 = 64 * MiB, OFF_WPOOL = 86 * MiB,
                 OFF_WINC = 87 * MiB, OFF_WUQ = 92 * MiB, OFF_WUKK = 95 * MiB, OFF_WUKV = 97 * MiB, OFF_WOC = 99 * MiB, OFF_WGU1 = 107 * MiB,
                 OFF_WD1 = 151 * MiB, OFF_XB = 173 * MiB, OFF_SMALL = 205 * MiB, OFF_R = 208 * MiB, WS_NEED = 369 * MiB;
constexpr size_t OFF_SSQ = OFF_SMALL;
constexpr size_t OFF_BAR = OFF_SMALL + 512 * 1024;
constexpr size_t OFF_CS = OFF_SMALL + 1 * MiB;
constexpr size_t OFF_U = OFF_R, OFF_VT = OFF_R + 16 * MiB, OFF_Z = OFF_R + 32 * MiB, OFF_DP = OFF_R + 64 * MiB, OFF_CAT = OFF_R + 80 * MiB;
constexpr size_t OFF_ACT = OFF_R;
constexpr size_t OFF_CQ = OFF_R, OFF_CKV = OFF_R + 8 * MiB, OFF_KR = OFF_R + 16 * MiB, OFF_Q = OFF_R + 17 * MiB, OFF_KN = OFF_R + 65 * MiB,
                 OFF_VT2 = OFF_R + 97 * MiB, OFF_O = OFF_R + 129 * MiB;

struct Params {
    const float* x; const float* g_mix; const float* g_ffn; const float* g_final; const float* w_in_ab; const float* g_v; const float* w_s;
    const float* b_s; const float* w_pool; const float* pool_scale; const float* w_out_ab; const float* w_in_c; const float* g_cq;
    const float* g_ckv; const float* w_uq; const float* w_ukv; const float* w_out_c; const float* w_gate; const float* w_up; const float* w_down;
    float* out; unsigned char* ws; int ph_lo, ph_hi;
};
typedef const __attribute__((address_space(4))) Params CP;
DI CP* kparams() { CP* kp = (CP*)__builtin_amdgcn_kernarg_segment_ptr(); asm volatile("" : "+s"(kp)); return kp; }
DI float shfl_xor_l(float v, int lane, int m) { return __int_as_float(__builtin_amdgcn_ds_bpermute((lane ^ m) << 2, __float_as_int(v))); }
DI int lane_id() { int l = __builtin_amdgcn_mbcnt_hi(-1, __builtin_amdgcn_mbcnt_lo(-1, 0)); asm volatile("" : "+v"(l)); return l; }
#define WSB(off) ((bf16_t*)(p.ws + (off)))
#define WSF(off) ((float*)(p.ws + (off)))
#define SSQ(i) ((float*)(p.ws + OFF_SSQ) + (i) * 8192)

constexpr int BM = 256, BK = 64, HALF = 128, HTB = HALF * BK * 2, NXCD = 8, WGM = 8;
DI int lds_byte(int r, int c) { const int st = (r >> 4) * 2 + (c >> 5), rr = r & 15, cc = c & 31, ob = rr * 64 + cc * 2; return st * 1024 + (ob ^ (((ob >> 9) & 1) << 5)); }
DI void stage_rc(int b, int& R, int& C) { const int st = b / 1024, sb = b % 1024, swz = sb ^ (((sb >> 9) & 1) << 5); R = (st >> 1) * 16 + swz / 64; C = (st & 1) * 32 + (swz % 64) / 2; }

struct Unit { const char* A; const char* B; int pm, pn, kind, half; };
struct Sub { const char* A; const char* B; int nM, nN, kind; int aStep, bStep, aPn, aHalf; };
enum { K_UZ = 0, K_VT, K_POOL, K_RES, K_SWIGLU, K_INC, K_Q, K_KN, K_VT2 };

struct Sched3 {
    Sub s0, s1, s2; int n0, n1, n2, G, c;
    DI static void map(const Sub& s, int wgid, Unit& u) {
        const int nwg = s.nM * s.nN;
        (void)nwg;
        const int nig = WGM * s.nN, gid = wgid / nig, fm = gid * WGM, gsz = (s.nM - fm) < WGM ? (s.nM - fm) : WGM;
        u.pm = fm + ((wgid % nig) % gsz); u.pn = (wgid % nig) / gsz;
        u.A = s.A + (size_t)u.pm * (size_t)s.aStep + (size_t)u.pn * (size_t)s.aPn; u.B = s.B + (size_t)u.pn * (size_t)s.bStep; u.kind = s.kind;
    }
    DI bool next(int i, Unit& u) const {
        const int n = n0 + n1 + n2, R = n / G, r = n - R * G; const bool split = (2 * r == G) && ((G & 15) == 0);
        long L = (long)i * G + c; int half = 0;
        if (split && i >= R) { if (i > R) return false; const int xcd = c & 7, idx = c >> 3; L = (long)R * G + (idx >> 1) * 8 + xcd; half = 1 + (idx & 1); }
        u.half = half;
        if (L < n0) { map(s0, (int)L, u); if (half == 2) u.A += s0.aHalf; return true; } L -= n0;
        if (L < n1) { map(s1, (int)L, u); if (half == 2) u.A += s1.aHalf; return true; } L -= n1;
        if (L < n2) { map(s2, (int)L, u); if (half == 2) u.A += s2.aHalf; return true; }
        return false;
    }
};
DI Sub mk_sub(const void* A, const void* B, int M, int N, int lda, int ldb, int kind, int aPn = 0) {
    Sub s; s.A = (const char*)A; s.B = (const char*)B; s.nM = M / BM; s.nN = N / BM; s.kind = kind; s.aStep = BM * lda * 2; s.bStep = BM * ldb * 2; s.aPn = aPn; s.aHalf = HALF * lda * 2; return s;
}

typedef f32x4 Acc[2][2][4][2];

template <class Epi>
DI void gemm_phase(LAS unsigned char* lds, int wid, int K, int lda, int ldb, bool bperm, const Sched3& S, const Epi& E) {
    const int lane = lane_id(), tid = wid * 64 + lane, wr = wid >> 2, wc = wid & 3, fr = lane & 15, fq = lane >> 4;
    const int nt = K / BK;
    unsigned voffA[2], voffB[2];
#pragma unroll
    for (int i = 0; i < 2; ++i) { int R, C; stage_rc(tid * 16 + i * 8192, R, C); const int rho = R & 31, Rb = bperm ? (R & ~31) + 8 * ((rho & 15) >> 2) + 4 * (rho >> 4) + (rho & 3) : R;
        voffA[i] = (unsigned)(R * lda + C) * 2u; voffB[i] = (unsigned)(Rb * ldb + C) * 2u; }
    const size_t kstep = (size_t)(BK * 2);
    const size_t hstepA = (size_t)HALF * lda * 2, hstepB = (size_t)HALF * ldb * 2;
    const unsigned ldsw = (unsigned)wid * 1024u;
    const int aoff = lds_byte(wr * 64 + fr, fq * 8), boff = lds_byte(wc * 32 + fr, fq * 8);
#define PG8_SA(b, h) (((b) * 2 + (h)) * HTB)
#define PG8_SB(b, h) ((4 + (b) * 2 + (h)) * HTB)
#define PG8_STAGE(bufoff, gbase, voff) do { _Pragma("unroll") for (int _i = 0; _i < 2; ++_i) \
        __builtin_amdgcn_global_load_lds((const unsigned*)((const char*)(gbase) + (voff)[_i]), (LAS unsigned*)(lds + (bufoff) + ldsw + _i * 8192), 16, 0, 0); } while (0)
#define PG8_LDA(dst, b, h) do { _Pragma("unroll") for (int m = 0; m < 4; ++m) _Pragma("unroll") for (int k = 0; k < 2; ++k) dst[m][k] = *(const LAS bf16x8*)(lds + PG8_SA(b, h) + aoff + m * 2048 + k * 1024); } while (0)
#define PG8_LDB(dst, b, h) do { _Pragma("unroll") for (int n = 0; n < 2; ++n) _Pragma("unroll") for (int k = 0; k < 2; ++k) dst[n][k] = *(const LAS bf16x8*)(lds + PG8_SB(b, h) + boff + n * 2048 + k * 1024); } while (0)
#define PG8_MMA(ai, bj, At, Bt) do { __builtin_amdgcn_s_setprio(1); _Pragma("unroll") for (int m = 0; m < 4; ++m) _Pragma("unroll") for (int n = 0; n < 2; ++n) _Pragma("unroll") for (int k = 0; k < 2; ++k) \
        acc[ai][bj][m][n] = __builtin_amdgcn_mfma_f32_16x16x32_bf16(Bt[n][k], At[m][k], acc[ai][bj][m][n], 0, 0, 0); __builtin_amdgcn_s_setprio(0); } while (0)
#define PG8_WAIT_V(n) asm volatile("s_waitcnt vmcnt(" #n ")" ::: "memory")
#define PG8_WAIT_L(n) asm volatile("s_waitcnt lgkmcnt(" #n ")" ::: "memory")
#define PG8_BAR __builtin_amdgcn_s_barrier()
#define PG8_SCHED __builtin_amdgcn_sched_barrier(0)
    Unit cur, nxt; int ui = 0;
    if (!S.next(0, cur)) return;
    Acc acc;
#pragma unroll
    for (int a = 0; a < 2; ++a)
#pragma unroll
        for (int b = 0; b < 2; ++b)
#pragma unroll
            for (int m = 0; m < 4; ++m)
#pragma unroll
                for (int n = 0; n < 2; ++n) acc[a][b][m][n] = (f32x4){0.f, 0.f, 0.f, 0.f};
    bf16x8 At[4][2], B0[2][2], B1[2][2];
    const char* cA = cur.A; const char* cB = cur.B; size_t hA = cur.half ? (size_t)0 : hstepA;
    PG8_STAGE(PG8_SB(0, 0), cB, voffB); PG8_STAGE(PG8_SA(0, 0), cA, voffA); PG8_STAGE(PG8_SB(0, 1), cB + hstepB, voffB); PG8_STAGE(PG8_SA(0, 1), cA + hA, voffA);
    if (wr == 1) PG8_BAR;
    PG8_WAIT_V(4); PG8_BAR;
    PG8_STAGE(PG8_SB(1, 0), cB + kstep, voffB); PG8_STAGE(PG8_SA(1, 0), cA + kstep, voffA); PG8_STAGE(PG8_SB(1, 1), cB + hstepB + kstep, voffB);
    PG8_WAIT_V(6); PG8_BAR;
    for (;;) {
        const bool has_next = S.next(ui + 1, nxt);
        const char* nA = has_next ? nxt.A : cA; const char* nB = has_next ? nxt.B : cB; const size_t nhA = has_next ? (nxt.half ? (size_t)0 : hstepA) : hA; const bool full = (cur.half == 0);
        for (int t = 0; t < nt; t += 2) {
            const bool last = (t == nt - 2);
            const char* a1 = cA + (size_t)(t + 1) * kstep;
            const char* a2 = last ? nA : cA + (size_t)(t + 2) * kstep; const char* b2 = last ? nB : cB + (size_t)(t + 2) * kstep;
            const char* a3 = a2 + kstep; const char* b3 = b2 + kstep; const size_t h2 = last ? nhA : hA;
            PG8_LDB(B0, 0, 0); PG8_SCHED; PG8_LDA(At, 0, 0); PG8_STAGE(PG8_SA(1, 1), a1 + hA, voffA);
            PG8_WAIT_L(8); PG8_BAR; PG8_WAIT_L(0); PG8_MMA(0, 0, At, B0); PG8_BAR; PG8_SCHED;
            PG8_LDB(B1, 0, 1); PG8_STAGE(PG8_SB(0, 0), b2, voffB);
            PG8_BAR; PG8_WAIT_L(0); PG8_MMA(0, 1, At, B1); PG8_BAR;
            PG8_LDA(At, 0, 1); PG8_STAGE(PG8_SA(0, 0), a2, voffA);
            PG8_BAR; PG8_WAIT_L(0); if (full) PG8_MMA(1, 0, At, B0); PG8_BAR; PG8_SCHED;
            PG8_STAGE(PG8_SB(0, 1), b2 + hstepB, voffB);
            PG8_WAIT_V(6); PG8_BAR; if (full) PG8_MMA(1, 1, At, B1); PG8_BAR;
            PG8_LDB(B0, 1, 0); PG8_SCHED; PG8_LDA(At, 1, 0); PG8_STAGE(PG8_SA(0, 1), a2 + h2, voffA);
            PG8_WAIT_L(8); PG8_BAR; PG8_WAIT_L(0); PG8_MMA(0, 0, At, B0); PG8_BAR; PG8_SCHED;
            PG8_LDB(B1, 1, 1); PG8_STAGE(PG8_SB(1, 0), b3, voffB);
            PG8_BAR; PG8_WAIT_L(0); PG8_MMA(0, 1, At, B1); PG8_BAR;
            PG8_LDA(At, 1, 1); PG8_STAGE(PG8_SA(1, 0), a3, voffA);
            PG8_BAR; PG8_WAIT_L(0); if (full) PG8_MMA(1, 0, At, B0); PG8_BAR; PG8_SCHED;
            PG8_STAGE(PG8_SB(1, 1), b3 + hstepB, voffB);
            PG8_WAIT_V(6); PG8_BAR; if (full) PG8_MMA(1, 1, At, B1); PG8_BAR;
        }
        E(acc, cur, wr, wc, fr, fq);
        if (!has_next) break;
#pragma unroll
        for (int a = 0; a < 2; ++a)
#pragma unroll
            for (int b = 0; b < 2; ++b)
#pragma unroll
                for (int m = 0; m < 4; ++m)
#pragma unroll
                    for (int n = 0; n < 2; ++n) acc[a][b][m][n] = (f32x4){0.f, 0.f, 0.f, 0.f};
        cur = nxt; cA = nA; cB = nB; hA = nhA; ++ui;
    }
    PG8_WAIT_V(0);
    if (wr == 0) PG8_BAR;
    PG8_BAR;
#undef PG8_SA
#undef PG8_SB
#undef PG8_STAGE
#undef PG8_LDA
#undef PG8_LDB
#undef PG8_MMA
#undef PG8_WAIT_V
#undef PG8_WAIT_L
#undef PG8_BAR
#undef PG8_SCHED
}

template <int PH> struct Epi {
    CP& p; bool dry; int sqo;
    DI void operator()(const Acc& acc, const Unit& u, int wr, int wc, int fr, int fq) const {
        if (dry) return;
        const bool hf = (u.half != 0);
        const int row0 = u.pm * BM + (u.half == 2 ? HALF : 0) + wr * 64 + fr, col0 = u.pn * BM + wc * 32 + 4 * fq;
#define ROWS8 _Pragma("unroll") for (int ai = 0; ai < 2; ++ai) _Pragma("unroll") for (int m = 0; m < 4; ++m) if (ai == 0 || !hf)
#define COLS4 _Pragma("unroll") for (int bj = 0; bj < 2; ++bj) _Pragma("unroll") for (int n = 0; n < 2; ++n)
#define ROWS8_ALL _Pragma("unroll") for (int ai = 0; ai < 2; ++ai) _Pragma("unroll") for (int m = 0; m < 4; ++m)
#define LOAD_ROW_RS(rsv, ssqp, invn) float rsv[2][4]; ROWS8_ALL rsv[ai][m] = (ssqp)[row0 + ai * HALF + m * 16]; ROWS8_ALL rsv[ai][m] = rstd_of(rsv[ai][m], invn)
#define LOAD_COL_RS(rsc, ssqp, invn) f32x4 rsc[2][2]; COLS4 rsc[bj][n] = *(const f32x4*)((ssqp) + col0 + bj * HALF + n * 16); \
        COLS4 rsc[bj][n] = (f32x4){rstd_of(rsc[bj][n][0], invn), rstd_of(rsc[bj][n][1], invn), rstd_of(rsc[bj][n][2], invn), rstd_of(rsc[bj][n][3], invn)}
        const int colp = u.pn * BM + wc * 32 + 8 * fq;
#define PK8(v0, v1) ({ const u32x2 h0_ = pk4(v0), h1_ = pk4(v1); (u32x4){h0_.x, h0_.y, h1_.x, h1_.y}; })
#define LOAD_COLP_RS(rsc, ssqp, invn) f32x4 rsc[2][2]; COLS4 rsc[bj][n] = *(const f32x4*)((ssqp) + colp + bj * HALF + n * 4); \
        COLS4 rsc[bj][n] = (f32x4){rstd_of(rsc[bj][n][0], invn), rstd_of(rsc[bj][n][1], invn), rstd_of(rsc[bj][n][2], invn), rstd_of(rsc[bj][n][3], invn)}
        if constexpr (PH == 1) {
            if (u.kind == K_UZ) {
                LOAD_ROW_RS(rsv, SSQ(0), 1.f / 2048.f);
                ROWS8 { const int r = row0 + ai * HALF + m * 16; const float rs = rsv[ai][m];
                    if (u.pn < 4) { bf16_t* dst = WSB(OFF_U) + (size_t)r * 1024 + colp;
#pragma unroll
                        for (int bj = 0; bj < 2; ++bj) { f32x4 v0 = acc[ai][bj][m][0] * rs, v1 = acc[ai][bj][m][1] * rs;
                            v0[0] = gelu_tanh(v0[0]); v0[1] = gelu_tanh(v0[1]); v0[2] = gelu_tanh(v0[2]); v0[3] = gelu_tanh(v0[3]);
                            v1[0] = gelu_tanh(v1[0]); v1[1] = gelu_tanh(v1[1]); v1[2] = gelu_tanh(v1[2]); v1[3] = gelu_tanh(v1[3]);
                            *(u32x4*)(dst + bj * HALF) = PK8(v0, v1); }
                    } else { float* dst = WSF(OFF_Z) + (size_t)r * 1024 + (colp - 1024);
                        COLS4 *(f32x4*)(dst + bj * HALF + n * 4) = acc[ai][bj][m][n] * rs;
                    }
                }
            } else {
                float* ssqv = SSQ(1 + sqo);
                LOAD_COLP_RS(rsc, SSQ(0), 1.f / 2048.f);
#pragma unroll
                for (int bj = 0; bj < 2; ++bj) { const int cc = colp + bj * HALF;
                    f32x4 sq0 = {0.f, 0.f, 0.f, 0.f}, sq1 = {0.f, 0.f, 0.f, 0.f};
                    ROWS8 { const int r = row0 + ai * HALF + m * 16; f32x4 v0 = acc[ai][bj][m][0] * rsc[bj][0], v1 = acc[ai][bj][m][1] * rsc[bj][1];
                        v0[0] = gelu_tanh(v0[0]); v0[1] = gelu_tanh(v0[1]); v0[2] = gelu_tanh(v0[2]); v0[3] = gelu_tanh(v0[3]);
                        v1[0] = gelu_tanh(v1[0]); v1[1] = gelu_tanh(v1[1]); v1[2] = gelu_tanh(v1[2]); v1[3] = gelu_tanh(v1[3]);
                        sq0 += v0 * v0; sq1 += v1 * v1; *(u32x4*)(WSB(OFF_VT) + (size_t)r * 8192 + cc) = PK8(v0, v1); }
#pragma unroll
                    for (int j = 0; j < 8; ++j) { float t = j < 4 ? sq0[j & 3] : sq1[j & 3];
                        t += __shfl_xor(t, 1); t += __shfl_xor(t, 2); t += __shfl_xor(t, 4); t += __shfl_xor(t, 8);
                        if (fr == 0) unsafeAtomicAdd(ssqv + cc + j, t); }
                }
            }
        } else if constexpr (PH == 3) {
            const int lc = wc * 32 + 8 * fq;
            f32x4 sc[2][2];
            COLS4 sc[bj][n] = *(const f32x4*)(p.pool_scale + u.pn * 256 + lc + bj * HALF + n * 4);
            ROWS8 { const int r = row0 + ai * HALF + m * 16; bf16_t* dst = WSB(OFF_CAT) + (size_t)r * 2048 + 1024 + u.pn * 256 + lc;
#pragma unroll
                for (int bj = 0; bj < 2; ++bj) *(u32x4*)(dst + bj * HALF) = PK8(acc[ai][bj][m][0] * sc[bj][0], acc[ai][bj][m][1] * sc[bj][1]); }
        } else if constexpr (PH == 4 || PH == 6 || PH == 10 || PH == 12) {
            float* ssq = SSQ((PH == 4 ? 2 : PH == 6 ? 3 : PH == 10 ? 6 : 7) + sqo);
            const int colp = u.pn * BM + wc * 32 + 8 * fq;
#pragma unroll
            for (int ai = 0; ai < 2; ++ai) if (ai == 0 || !hf) {
                f32x4 xo[4][2][2];
#pragma unroll
                for (int m = 0; m < 4; ++m) { const size_t o = (size_t)(row0 + ai * HALF + m * 16) * 2048 + colp;
                    if (PH == 4) { COLS4 xo[m][bj][n] = *(const f32x4*)(p.x + o + bj * HALF + n * 4); }
                    else {
#pragma unroll
                        for (int bj = 0; bj < 2; ++bj) { const u32x4 w = *(const u32x4*)(WSB(OFF_XB) + o + bj * HALF);
                            xo[m][bj][0] = (f32x4){bf_lo(w.x), bf_hi(w.x), bf_lo(w.y), bf_hi(w.y)}; xo[m][bj][1] = (f32x4){bf_lo(w.z), bf_hi(w.z), bf_lo(w.w), bf_hi(w.w)}; } } }
#pragma unroll
                for (int m = 0; m < 4; ++m) { const int r = row0 + ai * HALF + m * 16; const size_t o = (size_t)r * 2048 + colp; float part = 0.f;
#pragma unroll
                    for (int bj = 0; bj < 2; ++bj) { const f32x4 x0 = xo[m][bj][0] + acc[ai][bj][m][0], x1 = xo[m][bj][1] + acc[ai][bj][m][1];
                        const u32x2 h0 = pk4(x0), h1 = pk4(x1);
                        *(u32x4*)(WSB(OFF_XB) + o + bj * HALF) = (u32x4){h0.x, h0.y, h1.x, h1.y};
                        part += x0[0] * x0[0] + x0[1] * x0[1] + x0[2] * x0[2] + x0[3] * x0[3] + x1[0] * x1[0] + x1[1] * x1[1] + x1[2] * x1[2] + x1[3] * x1[3]; }
                    part += __shfl_xor(part, 16); part += __shfl_xor(part, 32);
                    if (fq == 0) unsafeAtomicAdd(ssq + r, part);
                }
            }
        } else if constexpr (PH == 5 || PH == 11) {
            LOAD_ROW_RS(rsv, SSQ(PH == 5 ? 2 : 6), 1.f / 2048.f);
            const int ac0 = u.pn * 128 + wc * 32 + 8 * fq;
            ROWS8 { const int r = row0 + ai * HALF + m * 16; const float rs = rsv[ai][m];
                u32x4 w;
#pragma unroll
                for (int bj = 0; bj < 2; ++bj) { const f32x4 g = acc[ai][bj][m][0] * rs, uu = acc[ai][bj][m][1] * rs;
                    f32x4 a; a[0] = silu_f(g[0]) * uu[0]; a[1] = silu_f(g[1]) * uu[1]; a[2] = silu_f(g[2]) * uu[2]; a[3] = silu_f(g[3]) * uu[3];
                    const u32x2 h = pk4(a); if (bj == 0) { w.x = h.x; w.y = h.y; } else { w.z = h.x; w.w = h.y; } }
                *(u32x4*)(WSB(OFF_ACT) + (size_t)r * DFF + ac0) = w;
            }
        } else if constexpr (PH == 7) {
            LOAD_ROW_RS(rsv, SSQ(3), 1.f / 2048.f);
            if (u.pn < 4) {
                bf16_t* dbase = (u.pn < 2) ? WSB(OFF_CQ) : WSB(OFF_CKV); float* sdst = (u.pn < 2) ? SSQ(4 + sqo) : SSQ(5 + sqo);
                const int cb = (u.pn & 1) * 256 + wc * 32 + 8 * fq;
                ROWS8 { const int r = row0 + ai * HALF + m * 16; const float rs = rsv[ai][m]; float part = 0.f;
                    bf16_t* dst = dbase + (size_t)r * 512 + cb;
#pragma unroll
                    for (int bj = 0; bj < 2; ++bj) { const f32x4 v0 = acc[ai][bj][m][0] * rs, v1 = acc[ai][bj][m][1] * rs; *(u32x4*)(dst + bj * HALF) = PK8(v0, v1);
                        part += v0[0] * v0[0] + v0[1] * v0[1] + v0[2] * v0[2] + v0[3] * v0[3] + v1[0] * v1[0] + v1[1] * v1[1] + v1[2] * v1[2] + v1[3] * v1[3]; }
                    part += __shfl_xor(part, 16); part += __shfl_xor(part, 32);
                    if (fq == 0) unsafeAtomicAdd(sdst + r, part);
                }
            } else if (wc < 2) {
                const int j0 = 16 * wc + 4 * fq; const float* cs = WSF(OFF_CS);
#pragma unroll
                for (int ai = 0; ai < 2; ++ai) if (ai == 0 || !hf) {
                    f32x4 c4[4], s4[4];
#pragma unroll
                    for (int m = 0; m < 4; ++m) { const int pos = (row0 + ai * HALF + m * 16) & (SEQ - 1); c4[m] = *(const f32x4*)(cs + pos * 32 + j0); s4[m] = *(const f32x4*)(cs + 4096 * 32 + pos * 32 + j0); }
#pragma unroll
                    for (int m = 0; m < 4; ++m) { const int r = row0 + ai * HALF + m * 16; const float rs = rsv[ai][m];
                        const f32x4 x1 = acc[ai][0][m][0] * rs, x2 = acc[ai][0][m][1] * rs;
                        bf16_t* dst = WSB(OFF_KR) + (size_t)r * 64 + j0;
                        *(u32x2*)(dst) = pk4(x1 * c4[m] - x2 * s4[m]); *(u32x2*)(dst + 32) = pk4(x2 * c4[m] + x1 * s4[m]); }
                }
            }
        } else if constexpr (PH == 8) {
            if (u.kind == K_Q) {
                LOAD_ROW_RS(rsv, SSQ(4), 1.f / 512.f);
                const float* cs = WSF(OFF_CS);
#pragma unroll
                for (int bj = 0; bj < 2; ++bj) {
                    const int g32 = u.pn * 8 + bj * 4 + wc, g64 = g32 >> 1; const bool rope = (g64 % 3) == 2;
                    if (!rope) {
                        ROWS8 { const int r = row0 + ai * HALF + m * 16; const float rs = rsv[ai][m] * QSCALE;
                            bf16_t* dst = WSB(OFF_Q) + (size_t)r * 3072 + g32 * 32 + 8 * fq; *(u32x4*)(dst) = PK8(acc[ai][bj][m][0] * rs, acc[ai][bj][m][1] * rs); }
                    } else {
                        const int j0 = 16 * (g32 & 1) + 4 * fq;
#pragma unroll
                        for (int ai = 0; ai < 2; ++ai) if (ai == 0 || !hf) {
                            f32x4 c4[4], s4[4];
#pragma unroll
                            for (int m = 0; m < 4; ++m) { const int pos = (row0 + ai * HALF + m * 16) & (SEQ - 1); c4[m] = *(const f32x4*)(cs + pos * 32 + j0); s4[m] = *(const f32x4*)(cs + 4096 * 32 + pos * 32 + j0); }
#pragma unroll
                            for (int m = 0; m < 4; ++m) { const int r = row0 + ai * HALF + m * 16; const float rs = rsv[ai][m] * QSCALE;
                                const f32x4 v0 = acc[ai][bj][m][0] * rs, v1 = acc[ai][bj][m][1] * rs;
                                bf16_t* dst = WSB(OFF_Q) + (size_t)r * 3072 + g64 * 64 + j0;
                                *(u32x2*)(dst) = pk4(v0 * c4[m] - v1 * s4[m]); *(u32x2*)(dst + 32) = pk4(v1 * c4[m] + v0 * s4[m]); }
                        }
                    }
                }
            } else if (u.kind == K_KN) {
                LOAD_ROW_RS(rsv, SSQ(5), 1.f / 512.f);
                ROWS8 { const int r = row0 + ai * HALF + m * 16; const float rs = rsv[ai][m];
                    bf16_t* dst = WSB(OFF_KN) + (size_t)r * 2048 + colp;
#pragma unroll
                    for (int bj = 0; bj < 2; ++bj) *(u32x4*)(dst + bj * HALF) = PK8(acc[ai][bj][m][0] * rs, acc[ai][bj][m][1] * rs); }
            } else {
                LOAD_COLP_RS(rsc, SSQ(5), 1.f / 512.f);
                ROWS8 { const int r = row0 + ai * HALF + m * 16; bf16_t* dst = WSB(OFF_VT2) + (size_t)r * 8192 + colp;
#pragma unroll
                    for (int bj = 0; bj < 2; ++bj) *(u32x4*)(dst + bj * HALF) = PK8(acc[ai][bj][m][0] * rsc[bj][0], acc[ai][bj][m][1] * rsc[bj][1]); }
            }
        }
#undef ROWS8
#undef PK8
#undef LOAD_COLP_RS
#undef ROWS8_ALL
#undef COLS4
#undef LOAD_ROW_RS
#undef LOAD_COL_RS
    }
};

template <int PH>
DI void run_gemm(CP& p, LAS unsigned char* lds, int wid, bool dry, int sqo, int K, int lda, int ldb, const Sub& s0, const Sub* s1, const Sub* s2) {
    Sched3 S; S.s0 = s0; S.n0 = s0.nM * s0.nN; S.s1 = s1 ? *s1 : s0; S.n1 = s1 ? s1->nM * s1->nN : 0; S.s2 = s2 ? *s2 : s0; S.n2 = s2 ? s2->nM * s2->nN : 0;
    S.G = gridDim.x; S.c = (gridDim.x == 256) ? (int)(((blockIdx.x & 31) << 3) | (blockIdx.x >> 5)) : (int)blockIdx.x;
    Epi<PH> E{p, dry, sqo};
    gemm_phase<Epi<PH>>(lds, wid, K, lda, ldb, PH == 1 || PH == 3 || PH == 7 || PH == 8, S, E);
}

enum { CM_ID = 0, CM_UZ, CM_GU, CM_POOL, CM_INC, CM_UQ, CM_UKVK, CM_UKVV, CM_P32 };
DI void conv_item(int lane, LAS unsigned char* wl, const float* src, const float* src2, const float* gain, bf16_t* dst, int ld, int K, int mode, int coff, int item) {
    const int nkc = K >> 8; const int pt = item / nkc, kc = item - pt * nkc;
    const bool gu = (mode == CM_GU);
#define CV_POS(i) (gu ? (pt >> 2) * 256 + (pt & 3) * 32 + ((i) & 31) + 128 * ((i) >> 5) : pt * 64 + (i))
    const int pp = CV_POS(lane), k0 = kc * 256; const float* s = src; long col = pp + coff; bool zero = false;
    if (mode == CM_UZ) col = pp < 1024 ? pp : pp + 1024;
    else if (mode == CM_GU) { const int n = (lane >> 4) & 1, r = lane & 15; col = (pt >> 2) * 128 + (pt & 3) * 32 + 8 * (r >> 2) + 4 * (lane >> 5) + (r & 3); s = n ? src2 : src; }
    else if (mode == CM_P32) { const int rho = pp & 31; col = (pp & ~31) + 8 * ((rho & 15) >> 2) + 4 * (rho >> 4) + (rho & 3); }
    else if (mode == CM_POOL) col = (long)(pp >> 8) * 65536 + (pp & 255);
    else if (mode == CM_INC) { if (pp >= 1088) { zero = true; col = 0; } else if (pp >= 1024) { const int q = pp - 1024, w = q >> 5, t = q & 31; col = 1024 + 32 * ((t >> 2) & 1) + 16 * w + 4 * (t >> 3) + (t & 3); } }
    else if (mode == CM_UQ) { const int g64 = pp >> 6; if ((g64 % 3) == 2) { const int q = pp & 63, w = q >> 5, t = q & 31; col = g64 * 64 + 32 * ((t >> 2) & 1) + 16 * w + 4 * (t >> 3) + (t & 3); } }
    else if (mode == CM_UKVK) col = (pp >> 7) * 256 + (pp & 127);
    else if (mode == CM_UKVV) col = (pp >> 7) * 256 + 128 + (pp & 127);
    const float* sp = s + (size_t)k0 * ld + col; bf16_t* dp = dst + (size_t)CV_POS(lane >> 3) * K + k0 + (lane & 7) * 8;
    const size_t rstep = (size_t)8 * K, hstep = (size_t)(gu ? 128 : 32) * K;
    for (int kb = 0; kb < 256; kb += 64) {
        float v[64];
#pragma unroll
        for (int j = 0; j < 64; ++j) v[j] = zero ? 0.f : __builtin_nontemporal_load(sp + (size_t)(kb + j) * ld);
        if (gain) {
#pragma unroll
            for (int j = 0; j < 64; ++j) v[j] *= gain[k0 + kb + j];
        }
#pragma unroll
        for (int q = 0; q < 8; ++q) { u32x4 w; w.x = pk2(v[8 * q], v[8 * q + 1]); w.y = pk2(v[8 * q + 2], v[8 * q + 3]); w.z = pk2(v[8 * q + 4], v[8 * q + 5]); w.w = pk2(v[8 * q + 6], v[8 * q + 7]);
            *(LAS u32x4*)(wl + lane * 144 + q * 16) = w; }
        asm volatile("" ::: "memory");
#pragma unroll
        for (int j = 0; j < 8; ++j) { const u32x4 w = *(const LAS u32x4*)(wl + (8 * j + (lane >> 3)) * 144 + (lane & 7) * 16); *(u32x4*)(dp + (j & 3) * rstep + (j >> 2) * hstep + kb) = w; }
        asm volatile("" ::: "memory");
    }
#undef CV_POS
}

DI void phase0(CP& p, LAS unsigned char* lds, int wid) {
    const int lane = lane_id(), tid = wid * 64 + lane;
    constexpr int NCONV = 5520, NXROW = 8192;
    const int gw = blockIdx.x * 8 + wid, nw = gridDim.x * 8;
    for (int it0 = gw; it0 < NCONV + NXROW; it0 += nw) {
        const int it = it0 < NCONV ? NCONV - 1 - it0 : it0;
        if (it < NCONV) {
            const float* src; const float* src2 = nullptr; const float* gain = nullptr; bf16_t* dst; int ld, K, mode = CM_ID, coff = 0, t0;
            if (it < 256) { src = p.w_in_ab; gain = p.g_mix; dst = WSB(OFF_W1UZ); ld = 3072; K = 2048; mode = CM_UZ; t0 = 0; }
            else if (it < 384) { src = p.w_in_ab; gain = p.g_mix; dst = WSB(OFF_W1V); ld = 3072; K = 2048; coff = 1024; t0 = 256; }
            else if (it < 640) { src = p.w_out_ab; dst = WSB(OFF_WOAB); ld = 2048; K = 2048; mode = CM_P32; t0 = 384; }
            else if (it < 2048) { src = p.w_gate; src2 = p.w_up; gain = p.g_ffn; dst = WSB(OFF_WGU0); ld = DFF; K = 2048; mode = CM_GU; t0 = 640; }
            else if (it < 2752) { src = p.w_down; dst = WSB(OFF_WD0); ld = 2048; K = DFF; mode = CM_P32; t0 = 2048; }
            else if (it < 2768) { src = p.w_pool; dst = WSB(OFF_WPOOL); ld = 256; K = 256; mode = CM_POOL; t0 = 2752; }
            else if (it < 2928) { src = p.w_in_c; gain = p.g_mix + 2048; dst = WSB(OFF_WINC); ld = 1088; K = 2048; mode = CM_INC; t0 = 2768; }
            else if (it < 3024) { src = p.w_uq; gain = p.g_cq; dst = WSB(OFF_WUQ); ld = 3072; K = 512; mode = CM_UQ; t0 = 2928; }
            else if (it < 3088) { src = p.w_ukv; gain = p.g_ckv; dst = WSB(OFF_WUKK); ld = 4096; K = 512; mode = CM_UKVK; t0 = 3024; }
            else if (it < 3152) { src = p.w_ukv; gain = p.g_ckv; dst = WSB(OFF_WUKV); ld = 4096; K = 512; mode = CM_UKVV; t0 = 3088; }
            else if (it < 3408) { src = p.w_out_c; dst = WSB(OFF_WOC); ld = 2048; K = 2048; mode = CM_P32; t0 = 3152; }
            else if (it < 4816) { src = p.w_gate + (size_t)2048 * DFF; src2 = p.w_up + (size_t)2048 * DFF; gain = p.g_ffn + 2048; dst = WSB(OFF_WGU1); ld = DFF; K = 2048; mode = CM_GU; t0 = 3408; }
            else { src = p.w_down + (size_t)DFF * 2048; dst = WSB(OFF_WD1); ld = 2048; K = DFF; mode = CM_P32; t0 = 4816; }
            conv_item(lane, lds + wid * 9216, src, src2, gain, dst, ld, K, mode, coff, it - t0);
        } else {
            const int row = it - NCONV; const f32x4* xr = (const f32x4*)(p.x + (size_t)row * 2048); bf16_t* xb = WSB(OFF_XB) + (size_t)row * 2048;
            float ss = 0.f;
#pragma unroll
            for (int i = 0; i < 8; ++i) { const f32x4 v = __builtin_nontemporal_load(xr + i * 64 + lane); ss += v[0] * v[0] + v[1] * v[1] + v[2] * v[2] + v[3] * v[3]; *(u32x2*)(xb + (i * 64 + lane) * 4) = pk4(v); }
#pragma unroll
            for (int o = 1; o < 64; o <<= 1) ss += __shfl_xor(ss, o);
            if (lane == 0) SSQ(0)[row] = ss;
        }
    }
    const int gt = blockIdx.x * NTHR + tid, gs = gridDim.x * NTHR;
    for (int i = gt; i < 7 * 8192; i += gs) SSQ(1)[i] = 0.f;
    float* cs = WSF(OFF_CS);
    for (int i = gt; i < 4096 * 32; i += gs) { const int pos = i >> 5, j = i & 31;
        const float inv_freq = exp2f(-(float)j * (13.287712379549449f / 32.f)); const float ang = (float)pos * inv_freq;
        float sn, cn; sincosf(ang, &sn, &cn); cs[i] = cn; cs[4096 * 32 + i] = sn; }
}

DI void phase2(CP& p, LAS unsigned char* lds, int wid) {
    const int lane = lane_id(), tid = wid * 64 + lane, fr = lane & 15, fq = lane >> 4;
    const float* Z = WSF(OFF_Z); bf16_t* DP = WSB(OFF_DP);
    LAS unsigned char* wm = lds; LAS float* rsl = (LAS float*)(lds + 36864);
    for (int it = blockIdx.x; it < 256 + 512; it += gridDim.x) {
        if (it < 256) {
            const int gt = it * NTHR + tid, c = (gt & 255) * 4, run = gt >> 8, g = c >> 8, win = 2 << g;
            const int t0 = run * 16, tb = t0 & (SEQ - 1);
            f32x4 sum = {0.f, 0.f, 0.f, 0.f};
            for (int j = 1; j < win; ++j) if (tb - j >= 0) sum += *(const f32x4*)(Z + (size_t)(t0 - j) * 1024 + c);
            for (int i = 0; i < 16; ++i) { const int t = t0 + i, pos = tb + i; const f32x4 zc = *(const f32x4*)(Z + (size_t)t * 1024 + c);
                sum += zc; const float cnt = (float)((pos + 1) < win ? (pos + 1) : win); const f32x4 d = sum / cnt - zc;
                *(u32x2*)(DP + (size_t)t * 1024 + c) = pk4(d);
                if (pos - win + 1 >= 0) sum -= *(const f32x4*)(Z + (size_t)(t - win + 1) * 1024 + c); }
        } else {
            const int item = it - 256, nb = item >> 3, h = item & 7, t0 = nb * 128;
            if (tid < 128) rsl[tid] = rstd_of(SSQ(1)[t0 + tid], 1.f / 1024.f);
            __syncthreads();
            { const int t = tid >> 2, sq = (tid & 3) * 32; const float* wrow = p.w_s + ((size_t)h * 128 + t) * 128 + sq;
#pragma unroll
              for (int e = 0; e < 4; ++e) { const f32x4 a = *(const f32x4*)(wrow + e * 8), b = *(const f32x4*)(wrow + e * 8 + 4); const int s0 = sq + e * 8;
                  const float mk = ((s0 >> 6) <= (t >> 6)) ? 1.f : 0.f;
                  u32x4 w; w.x = pk2(a[0] * mk * rsl[s0], a[1] * mk * rsl[s0 + 1]); w.y = pk2(a[2] * mk * rsl[s0 + 2], a[3] * mk * rsl[s0 + 3]);
                  w.z = pk2(b[0] * mk * rsl[s0 + 4], b[1] * mk * rsl[s0 + 5]); w.w = pk2(b[2] * mk * rsl[s0 + 6], b[3] * mk * rsl[s0 + 7]);
                  *(LAS u32x4*)(wm + t * 272 + s0 * 2) = w; } }
            __syncthreads();
            const int ch = h * 128 + 16 * wid + fr; const bf16_t* vt = WSB(OFF_VT) + (size_t)ch * 8192 + t0 + 8 * fq;
            bf16x8 bfr[4];
#pragma unroll
            for (int ks = 0; ks < 4; ++ks) bfr[ks] = *(const bf16x8*)(vt + 32 * ks);
            f32x4 acc[8];
#pragma unroll
            for (int tt = 0; tt < 8; ++tt) { acc[tt] = (f32x4){0.f, 0.f, 0.f, 0.f};
#pragma unroll
                for (int ks = 0; ks < 4; ++ks) { const bf16x8 af = *(const LAS bf16x8*)(wm + (16 * tt + fr) * 272 + (32 * ks + 8 * fq) * 2);
                    acc[tt] = __builtin_amdgcn_mfma_f32_16x16x32_bf16(bfr[ks], af, acc[tt], 0, 0, 0); } }
            const int d0 = h * 128 + 16 * wid + 4 * fq; const f32x4 gv = *(const f32x4*)(p.g_v + d0);
#pragma unroll
            for (int tt = 0; tt < 8; ++tt) { const int t = 16 * tt + fr, tok = t0 + t; const float bs = p.b_s[h * 128 + t];
                const u32x2 uw = *(const u32x2*)(WSB(OFF_U) + (size_t)tok * 1024 + d0);
                f32x4 a; a[0] = bf_lo(uw.x) * (acc[tt][0] * gv[0] + bs); a[1] = bf_hi(uw.x) * (acc[tt][1] * gv[1] + bs);
                a[2] = bf_lo(uw.y) * (acc[tt][2] * gv[2] + bs); a[3] = bf_hi(uw.y) * (acc[tt][3] * gv[3] + bs);
                *(u32x2*)(WSB(OFF_CAT) + (size_t)tok * 2048 + d0) = pk4(a); }
            __syncthreads();
        }
    }
}

constexpr int KROW = 400, VROW = 136, KBYTES = 64 * KROW, ABUF = KBYTES + 128 * VROW;
DI void attn_unit(LAS unsigned char* lds, int wid, int b, int h, int qb) {
    CP& p = *kparams();
    const int lane = lane_id(), tid = wid * 64 + lane, n = lane & 31, g = lane >> 5;
    const int q0 = qb * 256 + wid * 32, cq = q0 >> 6, nkt = 4 * qb + 4;
    const size_t tokq = (size_t)b * SEQ + q0 + n;
    const bf16_t* Q = WSB(OFF_Q); const bf16_t* KN = WSB(OFF_KN); const bf16_t* KR = WSB(OFF_KR); const bf16_t* VT = WSB(OFF_VT2);
    bf16x8 qf[12];
#pragma unroll
    for (int ks = 0; ks < 12; ++ks) qf[ks] = *(const bf16x8*)(Q + tokq * 3072 + h * 192 + ks * 16 + g * 8);
    f32x16 o[4];
#pragma unroll
    for (int dt = 0; dt < 4; ++dt)
#pragma unroll
        for (int i = 0; i < 16; ++i) o[dt][i] = 0.f;
    float mrow = -__builtin_inff(), lrow = 0.f;
    const int krow = tid >> 4, kc16 = tid & 15, rrow = tid >> 3, rc8 = tid & 7;
    const bf16_t* kn_src = KN + ((size_t)b * SEQ + krow) * 2048 + h * 128 + kc16 * 8;
    const bf16_t* kr_src = KR + ((size_t)b * SEQ + rrow) * 64 + rc8 * 8;
    const bf16_t* v_src = VT + ((size_t)h * 128 + rrow) * 8192 + (size_t)b * SEQ + rc8 * 8;
    const int kn_dst = krow * KROW + kc16 * 16, kr_dst = rrow * KROW + 256 + rc8 * 16, v_dst = KBYTES + rrow * VROW + rc8 * 16;
    u32x4 st0, st1, st2, st3, st4;
#define A_LOAD(kt) do { const size_t ko = (size_t)(kt) * 64; st0 = *(const u32x4*)(kn_src + ko * 2048); st1 = *(const u32x4*)(kn_src + (ko + 32) * 2048); \
        st2 = *(const u32x4*)(kr_src + ko * 64); st3 = *(const u32x4*)(v_src + ko); st4 = *(const u32x4*)(v_src + ko + (size_t)64 * 8192); } while (0)
#define A_WRITE(buf) do { LAS unsigned char* bb = lds + (buf) * ABUF; *(LAS u32x4*)(bb + kn_dst) = st0; *(LAS u32x4*)(bb + kn_dst + 32 * KROW) = st1; *(LAS u32x4*)(bb + kr_dst) = st2; \
        *(LAS u32x2*)(bb + v_dst) = (u32x2){st3.x, st3.y}; *(LAS u32x2*)(bb + v_dst + 8) = (u32x2){st3.z, st3.w}; \
        *(LAS u32x2*)(bb + v_dst + 64 * VROW) = (u32x2){st4.x, st4.y}; *(LAS u32x2*)(bb + v_dst + 64 * VROW + 8) = (u32x2){st4.z, st4.w}; } while (0)
    A_LOAD(0); A_WRITE(0); __syncthreads();
    for (int kt = 0; kt < nkt; ++kt) {
        const int buf = kt & 1;
        if (kt + 1 < nkt) A_LOAD(kt + 1);
        if (kt <= cq) {
            LAS unsigned char* kb = lds + buf * ABUF; LAS unsigned char* vb = kb + KBYTES;
            f32x16 s0, s1;
#pragma unroll
            for (int i = 0; i < 16; ++i) { s0[i] = 0.f; s1[i] = 0.f; }
#define KLD(ks, h) (*(const LAS bf16x8*)(kb + (n + 32 * (h)) * KROW + (ks) * 32 + g * 16))
#define VLD(dst, j, dt) do { LAS unsigned char* va_ = vb + (32 * (dt) + n) * VROW + (16 * (j) + 4 * g) * 2; const u32x2 lo_ = *(const LAS u32x2*)(va_), hi_ = *(const LAS u32x2*)(va_ + 16); dst = (u32x4){lo_.x, lo_.y, hi_.x, hi_.y}; } while (0)
            bf16x8 ka[3][2];
            ka[0][0] = KLD(0, 0); ka[0][1] = KLD(0, 1); ka[1][0] = KLD(1, 0); ka[1][1] = KLD(1, 1);
#pragma unroll
            for (int ks = 0; ks < 12; ++ks) {
                if (ks + 2 < 12) { ka[(ks + 2) % 3][0] = KLD(ks + 2, 0); ka[(ks + 2) % 3][1] = KLD(ks + 2, 1); }
                s0 = __builtin_amdgcn_mfma_f32_32x32x16_bf16(ka[ks % 3][0], qf[ks], s0, 0, 0, 0); s1 = __builtin_amdgcn_mfma_f32_32x32x16_bf16(ka[ks % 3][1], qf[ks], s1, 0, 0, 0);
                __builtin_amdgcn_sched_barrier(0); }
            u32x4 vf[2][4];
#pragma unroll
            for (int dt = 0; dt < 4; ++dt) VLD(vf[0][dt], 0, dt);
            float mx = s0[0];
#pragma unroll
            for (int i = 1; i < 16; ++i) mx = fmaxf(mx, s0[i]);
#pragma unroll
            for (int i = 0; i < 16; ++i) mx = fmaxf(mx, s1[i]);
            mx = fmaxf(mx, shfl_xor_l(mx, lane, 32));
            const float mnew = fmaxf(mrow, mx), alpha = __builtin_amdgcn_exp2f(mrow - mnew); mrow = mnew;
            float ls = 0.f;
#pragma unroll
            for (int i = 0; i < 16; ++i) { s0[i] = __builtin_amdgcn_exp2f(s0[i] - mnew); s1[i] = __builtin_amdgcn_exp2f(s1[i] - mnew); ls += s0[i] + s1[i]; }
            lrow = lrow * alpha + ls;
            if (__builtin_amdgcn_ballot_w64(alpha != 1.f) != 0ull) {
#pragma unroll
                for (int dt = 0; dt < 4; ++dt)
#pragma unroll
                    for (int i = 0; i < 16; ++i) o[dt][i] *= alpha;
            }
            bf16x8 pf[4];
#pragma unroll
            for (int jj = 0; jj < 2; ++jj) { u32x4 w0, w1;
                w0.x = pk2(s0[8 * jj + 0], s0[8 * jj + 1]); w0.y = pk2(s0[8 * jj + 2], s0[8 * jj + 3]); w0.z = pk2(s0[8 * jj + 4], s0[8 * jj + 5]); w0.w = pk2(s0[8 * jj + 6], s0[8 * jj + 7]);
                w1.x = pk2(s1[8 * jj + 0], s1[8 * jj + 1]); w1.y = pk2(s1[8 * jj + 2], s1[8 * jj + 3]); w1.z = pk2(s1[8 * jj + 4], s1[8 * jj + 5]); w1.w = pk2(s1[8 * jj + 6], s1[8 * jj + 7]);
                pf[jj] = __builtin_bit_cast(bf16x8, w0); pf[2 + jj] = __builtin_bit_cast(bf16x8, w1); }
#pragma unroll
            for (int j = 0; j < 4; ++j) {
                if (j < 3) {
#pragma unroll
                    for (int dt = 0; dt < 4; ++dt) VLD(vf[(j + 1) & 1][dt], j + 1, dt);
                }
#pragma unroll
                for (int dt = 0; dt < 4; ++dt) o[dt] = __builtin_amdgcn_mfma_f32_32x32x16_bf16(__builtin_bit_cast(bf16x8, vf[j & 1][dt]), pf[j], o[dt], 0, 0, 0);
                __builtin_amdgcn_sched_barrier(0); }
#undef KLD
#undef VLD
        }
        if (kt + 1 < nkt) A_WRITE(buf ^ 1);
        __syncthreads();
    }
#undef A_LOAD
#undef A_WRITE
    const float lt = lrow + shfl_xor_l(lrow, lane, 32), inv = 1.f / lt;
    LAS unsigned char* pt_ = lds + ABUF + wid * (32 * 272);
#pragma unroll
    for (int dt = 0; dt < 4; ++dt)
#pragma unroll
        for (int blk = 0; blk < 4; ++blk) { const f32x4 v = {o[dt][4 * blk] * inv, o[dt][4 * blk + 1] * inv, o[dt][4 * blk + 2] * inv, o[dt][4 * blk + 3] * inv};
            *(LAS u32x2*)(pt_ + n * 272 + (32 * dt + 8 * blk + 4 * g) * 2) = pk4(v); }
    asm volatile("" ::: "memory");
    bf16_t* od = WSB(OFF_O) + ((size_t)b * SEQ + q0 + (lane >> 4)) * 2048 + h * 128 + (lane & 15) * 8;
#pragma unroll
    for (int j = 0; j < 8; ++j) { const u32x4 w = *(const LAS u32x4*)(pt_ + (4 * j + (lane >> 4)) * 272 + (lane & 15) * 16); *(u32x4*)(od + (size_t)(4 * j) * 2048) = w; }
    asm volatile("" ::: "memory");
}
DI void phase_attn(CP& p, LAS unsigned char* lds, int wid) {
    for (int P = blockIdx.x; P < 256; P += gridDim.x) {
        const int xcd = P & 7, idx = P >> 3, bh = xcd * 4 + (idx >> 3), x = idx & 7, b = bh >> 4, h = bh & 15;
        attn_unit(lds, wid, b, h, 15 - x);
        attn_unit(lds, wid, b, h, x);
    }
}

DI void phase_final(CP& p, int wid) {
    const int lane = lane_id();
    for (int it = blockIdx.x; it < 1024; it += gridDim.x) {
        const int row = it * 8 + wid; const float rs = rstd_of(SSQ(7)[row], 1.f / 2048.f);
        const u32x4* xr = (const u32x4*)(WSB(OFF_XB) + (size_t)row * 2048); f32x4* orow = (f32x4*)(p.out + (size_t)row * 2048); const f32x4* gf = (const f32x4*)p.g_final;
#pragma unroll
        for (int i = 0; i < 4; ++i) { const u32x4 w = xr[i * 64 + lane]; const int c = (i * 64 + lane) * 2;
            const f32x4 a = {bf_lo(w.x), bf_hi(w.x), bf_lo(w.y), bf_hi(w.y)}, b = {bf_lo(w.z), bf_hi(w.z), bf_lo(w.w), bf_hi(w.w)};
            orow[c] = a * rs * gf[c]; orow[c + 1] = b * rs * gf[c + 1]; }
    }
}

#define XB_TMO      128
#define XB_XCNT(j)  (256  + 64 * (j))
#define XB_XSUB(j)  (1280 + 64 * (j))
#define XB_XGEN(j)  (2304 + 64 * (j))
#define XB_TOP      3328
#define XB_TOPGEN   3392
#define XCD_BAR_WORDS 3456
#define XB_SPIN_CAP (1u << 22)
DI unsigned xb_ld(unsigned* q) { return __hip_atomic_load(q, __ATOMIC_RELAXED, __HIP_MEMORY_SCOPE_AGENT); }
DI unsigned xb_add(unsigned* q, unsigned v) { return __hip_atomic_fetch_add(q, v, __ATOMIC_RELAXED, __HIP_MEMORY_SCOPE_AGENT); }
DI unsigned xb_xcc_id() { return (unsigned)__builtin_amdgcn_s_getreg((3 << 11) | 20) & 0xFu; }
#define XB_SPIN(cond, bar) do { unsigned _sp = 0; while (cond) { __builtin_amdgcn_s_sleep(1); \
    if ((++_sp & 255u) == 0u) { if (xb_ld(&(bar)[XB_TMO])) break; if (_sp > XB_SPIN_CAP) { atomicAdd(&(bar)[XB_TMO], 1u); break; } } } } while (0)
DI void xcd_barrier_complete(unsigned* bar, unsigned x, unsigned& nloc, unsigned& nx) {
    const unsigned G = gridDim.x;
    unsigned sum, cnt, mine, sp = 0u;
    for (;;) {
        sum = 0u; cnt = 0u; mine = 0u;
#pragma unroll
        for (unsigned j = 0; j < 16; ++j) { const unsigned c = xb_ld(&bar[XB_XCNT(j)]); sum += c; cnt += (c > 0u) ? 1u : 0u; mine = (j == x) ? c : mine; }
        if (sum == G) break;
        __builtin_amdgcn_s_sleep(1);
        if ((++sp & 255u) == 0u) { if (xb_ld(&bar[XB_TMO])) break; if (sp > XB_SPIN_CAP) { atomicAdd(&bar[XB_TMO], 1u); break; } }
    }
    nloc = mine > 0u ? mine : 1u; nx = cnt > 0u ? cnt : 1u;
}
DI void grid_bar(unsigned* bar, volatile LAS unsigned* st, int wid) {
    asm volatile("s_waitcnt vmcnt(0)" ::: "memory");
    __syncthreads();
    if (wid == 0) {
        if (lane_id() == 0) {
            __builtin_amdgcn_s_waitcnt(0);
            const unsigned x = xb_xcc_id();
            unsigned nloc = st[0], nx = st[1];
            if (nloc == 0u) { xcd_barrier_complete(bar, x, nloc, nx); st[0] = nloc; st[1] = nx; }
            const unsigned old = xb_add(&bar[XB_XSUB(x)], 1u);
            const unsigned gen = old / nloc;
            if (old + 1u == (gen + 1u) * nloc) {
                __builtin_amdgcn_fence(__ATOMIC_RELEASE, "agent");
                asm volatile("s_waitcnt vmcnt(0)" ::: "memory");
                const unsigned og = xb_add(&bar[XB_TOP], 1u);
                const unsigned tg = og / nx;
                if (og + 1u == (tg + 1u) * nx) xb_add(&bar[XB_TOPGEN], 1u);
                else XB_SPIN(xb_ld(&bar[XB_TOPGEN]) == tg, bar);
                __builtin_amdgcn_fence(__ATOMIC_ACQUIRE, "agent");
                xb_add(&bar[XB_XGEN(x)], 1u);
                asm volatile("s_waitcnt vmcnt(0)" ::: "memory");
            } else {
                XB_SPIN(xb_ld(&bar[XB_XGEN(x)]) == gen, bar);
                __builtin_amdgcn_fence(__ATOMIC_ACQUIRE, "agent");
                asm volatile("s_waitcnt vmcnt(0)" ::: "memory");
            }
        }
    }
    __syncthreads();
}

__global__ void __launch_bounds__(NTHR, 2) mega(Params pv) {
    extern __shared__ __attribute__((aligned(16))) unsigned char lds_raw[];
    LAS unsigned char* lds = (LAS unsigned char*)lds_raw;
    cg::grid_group grid = cg::this_grid();
    const int wid = __builtin_amdgcn_readfirstlane((int)threadIdx.x >> 6);
    const int ph_lo = pv.ph_lo, ph_hi = pv.ph_hi;
    if (ph_lo == 0x7fffffff) grid.sync();
    if (ph_hi - ph_lo > 1) {
        if (wid == 0 && lane_id() == 0) { volatile LAS unsigned* st = (volatile LAS unsigned*)(lds + LDS_MAIN); st[0] = 0u; st[1] = 0u;
            CP& p0 = *kparams(); (void)xb_add(&((unsigned*)(p0.ws + OFF_BAR))[XB_XCNT(xb_xcc_id())], 1u); }
        __syncthreads();
    }
    const bool probe_dry = PROBE_FULL ? false : (ph_hi == NPH); const int probe_sqo = (ph_hi == NPH) ? 8 : 0;
#ifdef ONLY_PH
#define IN(k) ((k) == ONLY_PH && ph_lo <= (k) && (k) < ph_hi)
#else
#define IN(k) (ph_lo <= (k) && (k) < ph_hi)
#endif
#define GP CP& p = *kparams()
#define RUNG(k, ...) do { if (PROBE_PH == (k)) run_gemm<k>(p, lds, wid, probe_dry, probe_sqo, __VA_ARGS__); run_gemm<k>(p, lds, wid, false, 0, __VA_ARGS__); } while (0)
#define SEAM(k) do { if (IN(k) && IN((k) + 1)) { GP; grid_bar((unsigned*)(p.ws + OFF_BAR), (volatile LAS unsigned*)(lds + LDS_MAIN), wid); if (PROBE_BAR) grid_bar((unsigned*)(p.ws + OFF_BAR), (volatile LAS unsigned*)(lds + LDS_MAIN), wid); } } while (0)
    if (IN(0)) { GP; if (PROBE_PH == 0) phase0(p, lds, wid); phase0(p, lds, wid); }
    SEAM(0);
    if (IN(1)) { GP; const Sub a = mk_sub(WSB(OFF_XB), WSB(OFF_W1UZ), MT, 2048, 2048, 2048, K_UZ), b = mk_sub(WSB(OFF_W1V), WSB(OFF_XB), 1024, MT, 2048, 2048, K_VT);
        RUNG(1, 2048, 2048, 2048, a, &b, nullptr); }
    SEAM(1);
    if (IN(2)) { GP; if (PROBE_PH == 2) phase2(p, lds, wid); phase2(p, lds, wid); }
    SEAM(2);
    if (IN(3)) { GP; const Sub a = mk_sub(WSB(OFF_DP), WSB(OFF_WPOOL), MT, 1024, 1024, 256, K_POOL, 512); RUNG(3, 256, 1024, 256, a, nullptr, nullptr); }
    SEAM(3);
    if (IN(4)) { GP; const Sub a = mk_sub(WSB(OFF_CAT), WSB(OFF_WOAB), MT, 2048, 2048, 2048, K_RES); RUNG(4, 2048, 2048, 2048, a, nullptr, nullptr); }
    SEAM(4);
    if (IN(5)) { GP; const Sub a = mk_sub(WSB(OFF_XB), WSB(OFF_WGU0), MT, 2 * DFF, 2048, 2048, K_SWIGLU); RUNG(5, 2048, 2048, 2048, a, nullptr, nullptr); }
    SEAM(5);
    if (IN(6)) { GP; const Sub a = mk_sub(WSB(OFF_ACT), WSB(OFF_WD0), MT, 2048, DFF, DFF, K_RES); RUNG(6, DFF, DFF, DFF, a, nullptr, nullptr); }
    SEAM(6);
    if (IN(7)) { GP; const Sub a = mk_sub(WSB(OFF_XB), WSB(OFF_WINC), MT, 1280, 2048, 2048, K_INC); RUNG(7, 2048, 2048, 2048, a, nullptr, nullptr); }
    SEAM(7);
    if (IN(8)) { GP; const Sub a = mk_sub(WSB(OFF_CQ), WSB(OFF_WUQ), MT, 3072, 512, 512, K_Q), b = mk_sub(WSB(OFF_CKV), WSB(OFF_WUKK), MT, 2048, 512, 512, K_KN),
                           c = mk_sub(WSB(OFF_WUKV), WSB(OFF_CKV), 2048, MT, 512, 512, K_VT2);
        RUNG(8, 512, 512, 512, a, &b, &c); }
    SEAM(8);
    if (IN(9)) { GP; if (PROBE_PH == 9) phase_attn(p, lds, wid); phase_attn(p, lds, wid); }
    SEAM(9);
    if (IN(10)) { GP; const Sub a = mk_sub(WSB(OFF_O), WSB(OFF_WOC), MT, 2048, 2048, 2048, K_RES); RUNG(10, 2048, 2048, 2048, a, nullptr, nullptr); }
    SEAM(10);
    if (IN(11)) { GP; const Sub a = mk_sub(WSB(OFF_XB), WSB(OFF_WGU1), MT, 2 * DFF, 2048, 2048, K_SWIGLU); RUNG(11, 2048, 2048, 2048, a, nullptr, nullptr); }
    SEAM(11);
    if (IN(12)) { GP; const Sub a = mk_sub(WSB(OFF_ACT), WSB(OFF_WD1), MT, 2048, DFF, DFF, K_RES); RUNG(12, DFF, DFF, DFF, a, nullptr, nullptr); }
    SEAM(12);
    if (IN(13)) { GP; phase_final(p, wid); }
}

extern "C" void kernel_launch(void* const* d_in, const int* in_sizes, int n_in, void* d_out, int out_size, void* d_ws, size_t ws_size, hipStream_t stream) {
    static int grid = 0;
    if (grid == 0) {
        if (n_in != 20 || ws_size < WS_NEED) { fprintf(stderr, "kernel_launch: unexpected n_in %d / ws_size %zu (need %zu)\n", n_in, ws_size, (size_t)WS_NEED); grid = -1; return; }
        int dev = 0, cus = 0, per = 0;
        (void)hipGetDevice(&dev); (void)hipDeviceGetAttribute(&cus, hipDeviceAttributeMultiprocessorCount, dev);
        if (hipFuncSetAttribute((const void*)mega, hipFuncAttributeMaxDynamicSharedMemorySize, LDS_BYTES) != hipSuccess) fprintf(stderr, "kernel_launch: hipFuncSetAttribute failed\n");
        if (hipOccupancyMaxActiveBlocksPerMultiprocessor(&per, (const void*)mega, NTHR, LDS_BYTES) != hipSuccess || per < 1) { fprintf(stderr, "kernel_launch: occupancy query gave %d\n", per); per = 1; }
        (void)hipGetLastError();
        grid = cus * per;
        fprintf(stderr, "kernel_launch: grid %d (cus %d x %d)\n", grid, cus, per);
    }
    if (grid < 0) return;
    Params p{};
    p.x = (const float*)d_in[0]; p.g_mix = (const float*)d_in[1]; p.g_ffn = (const float*)d_in[2]; p.g_final = (const float*)d_in[3]; p.w_in_ab = (const float*)d_in[4];
    p.g_v = (const float*)d_in[5]; p.w_s = (const float*)d_in[6]; p.b_s = (const float*)d_in[7]; p.w_pool = (const float*)d_in[8]; p.pool_scale = (const float*)d_in[9];
    p.w_out_ab = (const float*)d_in[10]; p.w_in_c = (const float*)d_in[11]; p.g_cq = (const float*)d_in[12]; p.g_ckv = (const float*)d_in[13]; p.w_uq = (const float*)d_in[14];
    p.w_ukv = (const float*)d_in[15]; p.w_out_c = (const float*)d_in[16]; p.w_gate = (const float*)d_in[17]; p.w_up = (const float*)d_in[18]; p.w_down = (const float*)d_in[19];
    p.out = (float*)d_out; p.ws = (unsigned char*)d_ws;
#if MEGA
    (void)hipMemsetAsync((char*)d_ws + OFF_BAR, 0, XCD_BAR_WORDS * 4, stream);
    p.ph_lo = 0; p.ph_hi = NPH;
    void* args[] = {&p};
    hipError_t e = hipLaunchCooperativeKernel((const void*)mega, dim3(grid), dim3(NTHR), args, LDS_BYTES, stream);
    if (e != hipSuccess) fprintf(stderr, "kernel_launch: cooperative launch failed: %s (grid %d)\n", hipGetErrorString(e), grid);
#else
    for (int k = 0; k < NPH; ++k) { p.ph_lo = k; p.ph_hi = k + 1; hipLaunchKernelGGL(mega, dim3(grid), dim3(NTHR), LDS_BYTES, stream, p); }
#endif
}
```

```cpp
#include <hip/hip_runtime.h>
#include <hip/hip_cooperative_groups.h>
#include <cstdio>
namespace cg = cooperative_groups;

#ifndef MEGA
#define MEGA 1
#endif
#ifndef PROBE_FULL
#define PROBE_FULL 0
#endif
#ifndef PROBE_BAR
#define PROBE_BAR 0
#endif
#ifndef PROBE_PH
#define PROBE_PH (-1)
#endif

#define LAS __attribute__((address_space(3)))
#define DI __device__ __forceinline__
typedef unsigned short bf16_t;
typedef short bf16x8 __attribute__((ext_vector_type(8)));
typedef float f32x4 __attribute__((ext_vector_type(4)));
typedef float f32x2 __attribute__((ext_vector_type(2)));
typedef float f32x16 __attribute__((ext_vector_type(16)));
typedef unsigned u32x4 __attribute__((ext_vector_type(4)));
typedef unsigned u32x2 __attribute__((ext_vector_type(2)));
typedef __bf16 bf16v2 __attribute__((ext_vector_type(2)));

DI unsigned pk2(float a, float b) { f32x2 f = {a, b}; bf16v2 r = __builtin_convertvector(f, bf16v2); return __builtin_bit_cast(unsigned, r); }
DI u32x2 pk4(f32x4 v) { u32x2 r; r.x = pk2(v[0], v[1]); r.y = pk2(v[2], v[3]); return r; }
DI float bf_lo(unsigned w) { return __uint_as_float(w << 16); }
DI float bf_hi(unsigned w) { return __uint_as_float(w & 0xffff0000u); }
DI float gelu_tanh(float x) { const float t = x * (1.5957691216f + 0.0713548163f * x * x); return x * __builtin_amdgcn_rcpf(1.f + __builtin_amdgcn_exp2f(-1.4426950409f * t)); }
DI float silu_f(float x) { return x * __builtin_amdgcn_rcpf(1.f + __builtin_amdgcn_exp2f(-1.4426950409f * x)); }
DI float rstd_of(float ssq, float inv_n) { return __builtin_amdgcn_rsqf(ssq * inv_n + 1e-6f); }

constexpr int MT = 8192, SEQ = 4096, DM = 2048, DFF = 5632;
constexpr int NTHR = 512, LDS_MAIN = 131072, LDS_BYTES = LDS_MAIN + 64;
constexpr int NPH = 14;
constexpr float QSCALE = 0.07216878364870322f * 1.4426950408889634f;

constexpr size_t MiB = 1048576;
constexpr size_t OFF_W1UZ = 0 * MiB, OFF_W1V = 8 * MiB, OFF_WOAB = 12 * MiB, OFF_WGU0 = 20 * MiB, OFF_WD0 = 64 * MiB, OFF_WPOOL = 86 * MiB,
                 OFF_WINC = 87 * MiB, OFF_WUQ = 92 * MiB, OFF_WUKK = 95 * MiB, OFF_WUKV = 97 * MiB, OFF_WOC = 99 * MiB, OFF_WGU1 = 107 * MiB,
                 OFF_WD1 = 151 * MiB, OFF_XB = 173 * MiB, OFF_SMALL = 205 * MiB, OFF_R = 208 * MiB, WS_NEED = 369 * MiB;
constexpr size_t OFF_SSQ = OFF_SMALL;
constexpr size_t OFF_BAR = OFF_SMALL + 512 * 1024;
constexpr size_t OFF_CS = OFF_SMALL + 1 * MiB;
constexpr size_t OFF_U = OFF_R, OFF_VT = OFF_R + 16 * MiB, OFF_Z = OFF_R + 32 * MiB, OFF_DP = OFF_R + 64 * MiB, OFF_CAT = OFF_R + 80 * MiB;
constexpr size_t OFF_ACT = OFF_R;
constexpr size_t OFF_CQ = OFF_R, OFF_CKV = OFF_R + 8 * MiB, OFF_KR = OFF_R + 16 * MiB, OFF_Q = OFF_R + 17 * MiB, OFF_KN = OFF_R + 65 * MiB,
                 OFF_VT2 = OFF_R + 97 * MiB, OFF_O = OFF_R + 129 * MiB;

struct Params {
    const float* x; const float* g_mix; const float* g_ffn; const float* g_final; const float* w_in_ab; const float* g_v; const float* w_s;
    const float* b_s; const float* w_pool; const float* pool_scale; const float* w_out_ab; const float* w_in_c; const float* g_cq;
    const float* g_ckv; const float* w_uq; const float* w_ukv; const float* w_out_c; const float* w_gate; const float* w_up; const float* w_down;
    float* out; unsigned char* ws; int ph_lo, ph_hi;
};
typedef const __attribute__((address_space(4))) Params CP;
DI CP* kparams() { CP* kp = (CP*)__builtin_amdgcn_kernarg_segment_ptr(); asm volatile("" : "+s"(kp)); return kp; }
DI float shfl_xor_l(float v, int lane, int m) { return __int_as_float(__builtin_amdgcn_ds_bpermute((lane ^ m) << 2, __float_as_int(v))); }
DI int lane_id() { int l = __builtin_amdgcn_mbcnt_hi(-1, __builtin_amdgcn_mbcnt_lo(-1, 0)); asm volatile("" : "+v"(l)); return l; }
#define WSB(off) ((bf16_t*)(p.ws + (off)))
#define WSF(off) ((float*)(p.ws + (off)))
#define SSQ(i) ((float*)(p.ws + OFF_SSQ) + (i) * 8192)

constexpr int BM = 256, BK = 64, HALF = 128, HTB = HALF * BK * 2, NXCD = 8, WGM = 8;
DI int lds_byte(int r, int c) { const int st = (r >> 4) * 2 + (c >> 5), rr = r & 15, cc = c & 31, ob = rr * 64 + cc * 2; return st * 1024 + (ob ^ (((ob >> 9) & 1) << 5)); }
DI void stage_rc(int b, int& R, int& C) { const int st = b / 1024, sb = b % 1024, swz = sb ^ (((sb >> 9) & 1) << 5); R = (st >> 1) * 16 + swz / 64; C = (st & 1) * 32 + (swz % 64) / 2; }

struct Unit { const char* A; const char* B; int pm, pn, kind, half; };
struct Sub { const char* A; const char* B; int nM, nN, kind; int aStep, bStep, aPn, aHalf; };
enum { K_UZ = 0, K_VT, K_POOL, K_RES, K_SWIGLU, K_INC, K_Q, K_KN, K_VT2 };

struct Sched3 {
    Sub s0, s1, s2; int n0, n1, n2, G, c;
    DI static void map(const Sub& s, int wgid, Unit& u) {
        const int nwg = s.nM * s.nN;
        { const int q = nwg / NXCD, r = nwg % NXCD, xcd = wgid % NXCD, off = wgid / NXCD; wgid = (xcd < r ? xcd * (q + 1) : r * (q + 1) + (xcd - r) * q) + off; }
        const int nig = WGM * s.nN, gid = wgid / nig, fm = gid * WGM, gsz = (s.nM - fm) < WGM ? (s.nM - fm) : WGM;
        u.pm = fm + ((wgid % nig) % gsz); u.pn = (wgid % nig) / gsz;
        u.A = s.A + (size_t)u.pm * (size_t)s.aStep + (size_t)u.pn * (size_t)s.aPn; u.B = s.B + (size_t)u.pn * (size_t)s.bStep; u.kind = s.kind;
    }
    DI bool next(int i, Unit& u) const {
        const int n = n0 + n1 + n2, R = n / G, r = n - R * G; const bool split = false && (2 * r == G) && ((G & 15) == 0);
        long L = (long)i * G + c; int half = 0;
        if (split && i >= R) { if (i > R) return false; const int xcd = c & 7, idx = c >> 3; L = (long)R * G + (idx >> 1) * 8 + xcd; half = 1 + (idx & 1); }
        u.half = half;
        if (L < n0) { map(s0, (int)L, u); if (half == 2) u.A += s0.aHalf; return true; } L -= n0;
        if (L < n1) { map(s1, (int)L, u); if (half == 2) u.A += s1.aHalf; return true; } L -= n1;
        if (L < n2) { map(s2, (int)L, u); if (half == 2) u.A += s2.aHalf; return true; }
        return false;
    }
};
DI Sub mk_sub(const void* A, const void* B, int M, int N, int lda, int ldb, int kind, int aPn = 0) {
    Sub s; s.A = (const char*)A; s.B = (const char*)B; s.nM = M / BM; s.nN = N / BM; s.kind = kind; s.aStep = BM * lda * 2; s.bStep = BM * ldb * 2; s.aPn = aPn; s.aHalf = HALF * lda * 2; return s;
}

typedef f32x4 Acc[2][2][4][2];

template <class Epi>
DI void gemm_phase(LAS unsigned char* lds, int wid, int K, int lda, int ldb, bool bperm, const Sched3& S, const Epi& E) {
    const int lane = lane_id(), tid = wid * 64 + lane, wr = wid >> 2, wc = wid & 3, fr = lane & 15, fq = lane >> 4;
    const int nt = K / BK;
    unsigned voffA[2], voffB[2];
#pragma unroll
    for (int i = 0; i < 2; ++i) { int R, C; stage_rc(tid * 16 + i * 8192, R, C); const int rho = R & 31, Rb = bperm ? (R & ~31) + 8 * ((rho & 15) >> 2) + 4 * (rho >> 4) + (rho & 3) : R;
        voffA[i] = (unsigned)(R * lda + C) * 2u; voffB[i] = (unsigned)(Rb * ldb + C) * 2u; }
    const size_t kstep = (size_t)(BK * 2);
    const size_t hstepA = (size_t)HALF * lda * 2, hstepB = (size_t)HALF * ldb * 2;
    const unsigned ldsw = (unsigned)wid * 1024u;
    const int aoff = lds_byte(wr * 64 + fr, fq * 8), boff = lds_byte(wc * 32 + fr, fq * 8);
#define PG8_SA(b, h) (((b) * 2 + (h)) * HTB)
#define PG8_SB(b, h) ((4 + (b) * 2 + (h)) * HTB)
#define PG8_STAGE(bufoff, gbase, voff) do { _Pragma("unroll") for (int _i = 0; _i < 2; ++_i) \
        __builtin_amdgcn_global_load_lds((const unsigned*)((const char*)(gbase) + (voff)[_i]), (LAS unsigned*)(lds + (bufoff) + ldsw + _i * 8192), 16, 0, 0); } while (0)
#define PG8_LDA(dst, b, h) do { _Pragma("unroll") for (int m = 0; m < 4; ++m) _Pragma("unroll") for (int k = 0; k < 2; ++k) dst[m][k] = *(const LAS bf16x8*)(lds + PG8_SA(b, h) + aoff + m * 2048 + k * 1024); } while (0)
#define PG8_LDB(dst, b, h) do { _Pragma("unroll") for (int n = 0; n < 2; ++n) _Pragma("unroll") for (int k = 0; k < 2; ++k) dst[n][k] = *(const LAS bf16x8*)(lds + PG8_SB(b, h) + boff + n * 2048 + k * 1024); } while (0)
#define PG8_MMA(ai, bj, At, Bt) do { __builtin_amdgcn_s_setprio(1); _Pragma("unroll") for (int m = 0; m < 4; ++m) _Pragma("unroll") for (int n = 0; n < 2; ++n) _Pragma("unroll") for (int k = 0; k < 2; ++k) \
        acc[ai][bj][m][n] = __builtin_amdgcn_mfma_f32_16x16x32_bf16(Bt[n][k], At[m][k], acc[ai][bj][m][n], 0, 0, 0); __builtin_amdgcn_s_setprio(0); } while (0)
#define PG8_WAIT_V(n) asm volatile("s_waitcnt vmcnt(" #n ")" ::: "memory")
#define PG8_WAIT_L(n) asm volatile("s_waitcnt lgkmcnt(" #n ")" ::: "memory")
#define PG8_BAR __builtin_amdgcn_s_barrier()
#define PG8_SCHED __builtin_amdgcn_sched_barrier(0)
    Unit cur, nxt; int ui = 0;
    if (!S.next(0, cur)) return;
    Acc acc;
#pragma unroll
    for (int a = 0; a < 2; ++a)
#pragma unroll
        for (int b = 0; b < 2; ++b)
#pragma unroll
            for (int m = 0; m < 4; ++m)
#pragma unroll
                for (int n = 0; n < 2; ++n) acc[a][b][m][n] = (f32x4){0.f, 0.f, 0.f, 0.f};
    bf16x8 At[4][2], B0[2][2], B1[2][2];
    const char* cA = cur.A; const char* cB = cur.B; size_t hA = cur.half ? (size_t)0 : hstepA;
    PG8_STAGE(PG8_SB(0, 0), cB, voffB); PG8_STAGE(PG8_SA(0, 0), cA, voffA); PG8_STAGE(PG8_SB(0, 1), cB + hstepB, voffB); PG8_STAGE(PG8_SA(0, 1), cA + hA, voffA);
    if (wr == 1) PG8_BAR;
    PG8_WAIT_V(4); PG8_BAR;
    PG8_STAGE(PG8_SB(1, 0), cB + kstep, voffB); PG8_STAGE(PG8_SA(1, 0), cA + kstep, voffA); PG8_STAGE(PG8_SB(1, 1), cB + hstepB + kstep, voffB);
    PG8_WAIT_V(6); PG8_BAR;
    for (;;) {
        const bool has_next = S.next(ui + 1, nxt);
        const char* nA = has_next ? nxt.A : cA; const char* nB = has_next ? nxt.B : cB; const size_t nhA = has_next ? (nxt.half ? (size_t)0 : hstepA) : hA; const bool full = (cur.half == 0);
        for (int t = 0; t < nt; t += 2) {
            const bool last = (t == nt - 2);
            const char* a1 = cA + (size_t)(t + 1) * kstep;
            const char* a2 = last ? nA : cA + (size_t)(t + 2) * kstep; const char* b2 = last ? nB : cB + (size_t)(t + 2) * kstep;
            const char* a3 = a2 + kstep; const char* b3 = b2 + kstep; const size_t h2 = last ? nhA : hA;
            PG8_LDB(B0, 0, 0); PG8_SCHED; PG8_LDA(At, 0, 0); PG8_STAGE(PG8_SA(1, 1), a1 + hA, voffA);
            PG8_WAIT_L(8); PG8_BAR; PG8_WAIT_L(0); PG8_MMA(0, 0, At, B0); PG8_BAR; PG8_SCHED;
            PG8_LDB(B1, 0, 1); PG8_STAGE(PG8_SB(0, 0), b2, voffB);
            PG8_BAR; PG8_WAIT_L(0); PG8_MMA(0, 1, At, B1); PG8_BAR;
            PG8_LDA(At, 0, 1); PG8_STAGE(PG8_SA(0, 0), a2, voffA);
            PG8_BAR; PG8_WAIT_L(0); if (full) PG8_MMA(1, 0, At, B0); PG8_BAR; PG8_SCHED;
            PG8_STAGE(PG8_SB(0, 1), b2 + hstepB, voffB);
            PG8_WAIT_V(6); PG8_BAR; if (full) PG8_MMA(1, 1, At, B1); PG8_BAR;
            PG8_LDB(B0, 1, 0); PG8_SCHED; PG8_LDA(At, 1, 0); PG8_STAGE(PG8_SA(0, 1), a2 + h2, voffA);
            PG8_WAIT_L(8); PG8_BAR; PG8_WAIT_L(0); PG8_MMA(0, 0, At, B0); PG8_BAR; PG8_SCHED;
            PG8_LDB(B1, 1, 1); PG8_STAGE(PG8_SB(1, 0), b3, voffB);
            PG8_BAR; PG8_WAIT_L(0); PG8_MMA(0, 1, At, B1); PG8_BAR;
            PG8_LDA(At, 1, 1); PG8_STAGE(PG8_SA(1, 0), a3, voffA);
            PG8_BAR; PG8_WAIT_L(0); if (full) PG8_MMA(1, 0, At, B0); PG8_BAR; PG8_SCHED;
            PG8_STAGE(PG8_SB(1, 1), b3 + hstepB, voffB);
            PG8_WAIT_V(6); PG8_BAR; if (full) PG8_MMA(1, 1, At, B1); PG8_BAR;
        }
        E(acc, cur, wr, wc, fr, fq);
        if (!has_next) break;
#pragma unroll
        for (int a = 0; a < 2; ++a)
#pragma unroll
            for (int b = 0; b < 2; ++b)
#pragma unroll
                for (int m = 0; m < 4; ++m)
#pragma unroll
                    for (int n = 0; n < 2; ++n) acc[a][b][m][n] = (f32x4){0.f, 0.f, 0.f, 0.f};
        cur = nxt; cA = nA; cB = nB; hA = nhA; ++ui;
    }
    PG8_WAIT_V(0);
    if (wr == 0) PG8_BAR;
    PG8_BAR;
#undef PG8_SA
#undef PG8_SB
#undef PG8_STAGE
#undef PG8_LDA
#undef PG8_LDB
#undef PG8_MMA
#undef PG8_WAIT_V
#undef PG8_WAIT_L
#undef PG8_BAR
#undef PG8_SCHED
}

template <int PH> struct Epi {
    CP& p; bool dry; int sqo;
    DI void operator()(const Acc& acc, const Unit& u, int wr, int wc, int fr, int fq) const {
        if (dry) return;
        const bool hf = (u.half != 0);
        const int row0 = u.pm * BM + (u.half == 2 ? HALF : 0) + wr * 64 + fr, col0 = u.pn * BM + wc * 32 + 4 * fq;
#define ROWS8 _Pragma("unroll") for (int ai = 0; ai < 2; ++ai) _Pragma("unroll") for (int m = 0; m < 4; ++m) if (ai == 0 || !hf)
#define COLS4 _Pragma("unroll") for (int bj = 0; bj < 2; ++bj) _Pragma("unroll") for (int n = 0; n < 2; ++n)
#define ROWS8_ALL _Pragma("unroll") for (int ai = 0; ai < 2; ++ai) _Pragma("unroll") for (int m = 0; m < 4; ++m)
#define LOAD_ROW_RS(rsv, ssqp, invn) float rsv[2][4]; ROWS8_ALL rsv[ai][m] = (ssqp)[row0 + ai * HALF + m * 16]; ROWS8_ALL rsv[ai][m] = rstd_of(rsv[ai][m], invn)
#define LOAD_COL_RS(rsc, ssqp, invn) f32x4 rsc[2][2]; COLS4 rsc[bj][n] = *(const f32x4*)((ssqp) + col0 + bj * HALF + n * 16); \
        COLS4 rsc[bj][n] = (f32x4){rstd_of(rsc[bj][n][0], invn), rstd_of(rsc[bj][n][1], invn), rstd_of(rsc[bj][n][2], invn), rstd_of(rsc[bj][n][3], invn)}
        const int colp = u.pn * BM + wc * 32 + 8 * fq;
#define PK8(v0, v1) ({ const u32x2 h0_ = pk4(v0), h1_ = pk4(v1); (u32x4){h0_.x, h0_.y, h1_.x, h1_.y}; })
#define LOAD_COLP_RS(rsc, ssqp, invn) f32x4 rsc[2][2]; COLS4 rsc[bj][n] = *(const f32x4*)((ssqp) + colp + bj * HALF + n * 4); \
        COLS4 rsc[bj][n] = (f32x4){rstd_of(rsc[bj][n][0], invn), rstd_of(rsc[bj][n][1], invn), rstd_of(rsc[bj][n][2], invn), rstd_of(rsc[bj][n][3], invn)}
        if constexpr (PH == 1) {
            if (u.kind == K_UZ) {
                LOAD_ROW_RS(rsv, SSQ(0), 1.f / 2048.f);
                ROWS8 { const int r = row0 + ai * HALF + m * 16; const float rs = rsv[ai][m];
                    if (u.pn < 4) { bf16_t* dst = WSB(OFF_U) + (size_t)r * 1024 + colp;
#pragma unroll
                        for (int bj = 0; bj < 2; ++bj) { f32x4 v0 = acc[ai][bj][m][0] * rs, v1 = acc[ai][bj][m][1] * rs;
                            v0[0] = gelu_tanh(v0[0]); v0[1] = gelu_tanh(v0[1]); v0[2] = gelu_tanh(v0[2]); v0[3] = gelu_tanh(v0[3]);
                            v1[0] = gelu_tanh(v1[0]); v1[1] = gelu_tanh(v1[1]); v1[2] = gelu_tanh(v1[2]); v1[3] = gelu_tanh(v1[3]);
                            *(u32x4*)(dst + bj * HALF) = PK8(v0, v1); }
                    } else { float* dst = WSF(OFF_Z) + (size_t)r * 1024 + (colp - 1024);
                        COLS4 *(f32x4*)(dst + bj * HALF + n * 4) = acc[ai][bj][m][n] * rs;
                    }
                }
            } else {
                float* ssqv = SSQ(1 + sqo);
                LOAD_COLP_RS(rsc, SSQ(0), 1.f / 2048.f);
#pragma unroll
                for (int bj = 0; bj < 2; ++bj) { const int cc = colp + bj * HALF;
                    f32x4 sq0 = {0.f, 0.f, 0.f, 0.f}, sq1 = {0.f, 0.f, 0.f, 0.f};
                    ROWS8 { const int r = row0 + ai * HALF + m * 16; f32x4 v0 = acc[ai][bj][m][0] * rsc[bj][0], v1 = acc[ai][bj][m][1] * rsc[bj][1];
                        v0[0] = gelu_tanh(v0[0]); v0[1] = gelu_tanh(v0[1]); v0[2] = gelu_tanh(v0[2]); v0[3] = gelu_tanh(v0[3]);
                        v1[0] = gelu_tanh(v1[0]); v1[1] = gelu_tanh(v1[1]); v1[2] = gelu_tanh(v1[2]); v1[3] = gelu_tanh(v1[3]);
                        sq0 += v0 * v0; sq1 += v1 * v1; *(u32x4*)(WSB(OFF_VT) + (size_t)r * 8192 + cc) = PK8(v0, v1); }
#pragma unroll
                    for (int j = 0; j < 8; ++j) { float t = j < 4 ? sq0[j & 3] : sq1[j & 3];
                        t += __shfl_xor(t, 1); t += __shfl_xor(t, 2); t += __shfl_xor(t, 4); t += __shfl_xor(t, 8);
                        if (fr == 0) unsafeAtomicAdd(ssqv + cc + j, t); }
                }
            }
        } else if constexpr (PH == 3) {
            const int lc = wc * 32 + 8 * fq;
            f32x4 sc[2][2];
            COLS4 sc[bj][n] = *(const f32x4*)(p.pool_scale + u.pn * 256 + lc + bj * HALF + n * 4);
            ROWS8 { const int r = row0 + ai * HALF + m * 16; bf16_t* dst = WSB(OFF_CAT) + (size_t)r * 2048 + 1024 + u.pn * 256 + lc;
#pragma unroll
                for (int bj = 0; bj < 2; ++bj) *(u32x4*)(dst + bj * HALF) = PK8(acc[ai][bj][m][0] * sc[bj][0], acc[ai][bj][m][1] * sc[bj][1]); }
        } else if constexpr (PH == 4 || PH == 6 || PH == 10 || PH == 12) {
            float* ssq = SSQ((PH == 4 ? 2 : PH == 6 ? 3 : PH == 10 ? 6 : 7) + sqo);
            const int colp = u.pn * BM + wc * 32 + 8 * fq;
#pragma unroll
            for (int ai = 0; ai < 2; ++ai) if (ai == 0 || !hf) {
                f32x4 xo[4][2][2];
#pragma unroll
                for (int m = 0; m < 4; ++m) { const size_t o = (size_t)(row0 + ai * HALF + m * 16) * 2048 + colp;
                    if (PH == 4) { COLS4 xo[m][bj][n] = *(const f32x4*)(p.x + o + bj * HALF + n * 4); }
                    else {
#pragma unroll
                        for (int bj = 0; bj < 2; ++bj) { const u32x4 w = *(const u32x4*)(WSB(OFF_XB) + o + bj * HALF);
                            xo[m][bj][0] = (f32x4){bf_lo(w.x), bf_hi(w.x), bf_lo(w.y), bf_hi(w.y)}; xo[m][bj][1] = (f32x4){bf_lo(w.z), bf_hi(w.z), bf_lo(w.w), bf_hi(w.w)}; } } }
#pragma unroll
                for (int m = 0; m < 4; ++m) { const int r = row0 + ai * HALF + m * 16; const size_t o = (size_t)r * 2048 + colp; float part = 0.f;
#pragma unroll
                    for (int bj = 0; bj < 2; ++bj) { const f32x4 x0 = xo[m][bj][0] + acc[ai][bj][m][0], x1 = xo[m][bj][1] + acc[ai][bj][m][1];
                        const u32x2 h0 = pk4(x0), h1 = pk4(x1);
                        *(u32x4*)(WSB(OFF_XB) + o + bj * HALF) = (u32x4){h0.x, h0.y, h1.x, h1.y};
                        part += x0[0] * x0[0] + x0[1] * x0[1] + x0[2] * x0[2] + x0[3] * x0[3] + x1[0] * x1[0] + x1[1] * x1[1] + x1[2] * x1[2] + x1[3] * x1[3]; }
                    part += __shfl_xor(part, 16); part += __shfl_xor(part, 32);
                    if (fq == 0) unsafeAtomicAdd(ssq + r, part);
                }
            }
        } else if constexpr (PH == 5 || PH == 11) {
            LOAD_ROW_RS(rsv, SSQ(PH == 5 ? 2 : 6), 1.f / 2048.f);
            const int ac0 = u.pn * 128 + wc * 32 + 8 * fq;
            ROWS8 { const int r = row0 + ai * HALF + m * 16; const float rs = rsv[ai][m];
                u32x4 w;
#pragma unroll
                for (int bj = 0; bj < 2; ++bj) { const f32x4 g = acc[ai][bj][m][0] * rs, uu = acc[ai][bj][m][1] * rs;
                    f32x4 a; a[0] = silu_f(g[0]) * uu[0]; a[1] = silu_f(g[1]) * uu[1]; a[2] = silu_f(g[2]) * uu[2]; a[3] = silu_f(g[3]) * uu[3];
                    const u32x2 h = pk4(a); if (bj == 0) { w.x = h.x; w.y = h.y; } else { w.z = h.x; w.w = h.y; } }
                *(u32x4*)(WSB(OFF_ACT) + (size_t)r * DFF + ac0) = w;
            }
        } else if constexpr (PH == 7) {
            LOAD_ROW_RS(rsv, SSQ(3), 1.f / 2048.f);
            if (u.pn < 4) {
                bf16_t* dbase = (u.pn < 2) ? WSB(OFF_CQ) : WSB(OFF_CKV); float* sdst = (u.pn < 2) ? SSQ(4 + sqo) : SSQ(5 + sqo);
                const int cb = (u.pn & 1) * 256 + wc * 32 + 8 * fq;
                ROWS8 { const int r = row0 + ai * HALF + m * 16; const float rs = rsv[ai][m]; float part = 0.f;
                    bf16_t* dst = dbase + (size_t)r * 512 + cb;
#pragma unroll
                    for (int bj = 0; bj < 2; ++bj) { const f32x4 v0 = acc[ai][bj][m][0] * rs, v1 = acc[ai][bj][m][1] * rs; *(u32x4*)(dst + bj * HALF) = PK8(v0, v1);
                        part += v0[0] * v0[0] + v0[1] * v0[1] + v0[2] * v0[2] + v0[3] * v0[3] + v1[0] * v1[0] + v1[1] * v1[1] + v1[2] * v1[2] + v1[3] * v1[3]; }
                    part += __shfl_xor(part, 16); part += __shfl_xor(part, 32);
                    if (fq == 0) unsafeAtomicAdd(sdst + r, part);
                }
            } else if (wc < 2) {
                const int j0 = 16 * wc + 4 * fq; const float* cs = WSF(OFF_CS);
#pragma unroll
                for (int ai = 0; ai < 2; ++ai) if (ai == 0 || !hf) {
                    f32x4 c4[4], s4[4];
#pragma unroll
                    for (int m = 0; m < 4; ++m) { const int pos = (row0 + ai * HALF + m * 16) & (SEQ - 1); c4[m] = *(const f32x4*)(cs + pos * 32 + j0); s4[m] = *(const f32x4*)(cs + 4096 * 32 + pos * 32 + j0); }
#pragma unroll
                    for (int m = 0; m < 4; ++m) { const int r = row0 + ai * HALF + m * 16; const float rs = rsv[ai][m];
                        const f32x4 x1 = acc[ai][0][m][0] * rs, x2 = acc[ai][0][m][1] * rs;
                        bf16_t* dst = WSB(OFF_KR) + (size_t)r * 64 + j0;
                        *(u32x2*)(dst) = pk4(x1 * c4[m] - x2 * s4[m]); *(u32x2*)(dst + 32) = pk4(x2 * c4[m] + x1 * s4[m]); }
                }
            }
        } else if constexpr (PH == 8) {
            if (u.kind == K_Q) {
                LOAD_ROW_RS(rsv, SSQ(4), 1.f / 512.f);
                const float* cs = WSF(OFF_CS);
#pragma unroll
                for (int bj = 0; bj < 2; ++bj) {
                    const int g32 = u.pn * 8 + bj * 4 + wc, g64 = g32 >> 1; const bool rope = (g64 % 3) == 2;
                    if (!rope) {
                        ROWS8 { const int r = row0 + ai * HALF + m * 16; const float rs = rsv[ai][m] * QSCALE;
                            bf16_t* dst = WSB(OFF_Q) + (size_t)r * 3072 + g32 * 32 + 8 * fq; *(u32x4*)(dst) = PK8(acc[ai][bj][m][0] * rs, acc[ai][bj][m][1] * rs); }
                    } else {
                        const int j0 = 16 * (g32 & 1) + 4 * fq;
#pragma unroll
                        for (int ai = 0; ai < 2; ++ai) if (ai == 0 || !hf) {
                            f32x4 c4[4], s4[4];
#pragma unroll
                            for (int m = 0; m < 4; ++m) { const int pos = (row0 + ai * HALF + m * 16) & (SEQ - 1); c4[m] = *(const f32x4*)(cs + pos * 32 + j0); s4[m] = *(const f32x4*)(cs + 4096 * 32 + pos * 32 + j0); }
#pragma unroll
                            for (int m = 0; m < 4; ++m) { const int r = row0 + ai * HALF + m * 16; const float rs = rsv[ai][m] * QSCALE;
                                const f32x4 v0 = acc[ai][bj][m][0] * rs, v1 = acc[ai][bj][m][1] * rs;
                                bf16_t* dst = WSB(OFF_Q) + (size_t)r * 3072 + g64 * 64 + j0;
                                *(u32x2*)(dst) = pk4(v0 * c4[m] - v1 * s4[m]); *(u32x2*)(dst + 32) = pk4(v1 * c4[m] + v0 * s4[m]); }
                        }
                    }
                }
            } else if (u.kind == K_KN) {
                LOAD_ROW_RS(rsv, SSQ(5), 1.f / 512.f);
                ROWS8 { const int r = row0 + ai * HALF + m * 16; const float rs = rsv[ai][m];
                    bf16_t* dst = WSB(OFF_KN) + (size_t)r * 2048 + colp;
#pragma unroll
                    for (int bj = 0; bj < 2; ++bj) *(u32x4*)(dst + bj * HALF) = PK8(acc[ai][bj][m][0] * rs, acc[ai][bj][m][1] * rs); }
            } else {
                LOAD_COLP_RS(rsc, SSQ(5), 1.f / 512.f);
                ROWS8 { const int r = row0 + ai * HALF + m * 16; bf16_t* dst = WSB(OFF_VT2) + (size_t)r * 8192 + colp;
#pragma unroll
                    for (int bj = 0; bj < 2; ++bj) *(u32x4*)(dst + bj * HALF) = PK8(acc[ai][bj][m][0] * rsc[bj][0], acc[ai][bj][m][1] * rsc[bj][1]); }
            }
        }
#undef ROWS8
#undef PK8
#undef LOAD_COLP_RS
#undef ROWS8_ALL
#undef COLS4
#undef LOAD_ROW_RS
#undef LOAD_COL_RS
    }
};

template <int PH>
DI void run_gemm(CP& p, LAS unsigned char* lds, int wid, bool dry, int sqo, int K, int lda, int ldb, const Sub& s0, const Sub* s1, const Sub* s2) {
    Sched3 S; S.s0 = s0; S.n0 = s0.nM * s0.nN; S.s1 = s1 ? *s1 : s0; S.n1 = s1 ? s1->nM * s1->nN : 0; S.s2 = s2 ? *s2 : s0; S.n2 = s2 ? s2->nM * s2->nN : 0;
    S.G = gridDim.x; S.c = (gridDim.x == 256) ? (int)(((blockIdx.x & 31) << 3) | (blockIdx.x >> 5)) : (int)blockIdx.x;
    Epi<PH> E{p, dry, sqo};
    gemm_phase<Epi<PH>>(lds, wid, K, lda, ldb, PH == 1 || PH == 3 || PH == 7 || PH == 8, S, E);
}

enum { CM_ID = 0, CM_UZ, CM_GU, CM_POOL, CM_INC, CM_UQ, CM_UKVK, CM_UKVV, CM_P32 };
DI void conv_item(int lane, LAS unsigned char* wl, const float* src, const float* src2, const float* gain, bf16_t* dst, int ld, int K, int mode, int coff, int item) {
    const int nkc = K >> 8; const int pt = item / nkc, kc = item - pt * nkc;
    const bool gu = (mode == CM_GU);
#define CV_POS(i) (gu ? (pt >> 2) * 256 + (pt & 3) * 32 + ((i) & 31) + 128 * ((i) >> 5) : pt * 64 + (i))
    const int pp = CV_POS(lane), k0 = kc * 256; const float* s = src; long col = pp + coff; bool zero = false;
    if (mode == CM_UZ) col = pp < 1024 ? pp : pp + 1024;
    else if (mode == CM_GU) { const int n = (lane >> 4) & 1, r = lane & 15; col = (pt >> 2) * 128 + (pt & 3) * 32 + 8 * (r >> 2) + 4 * (lane >> 5) + (r & 3); s = n ? src2 : src; }
    else if (mode == CM_P32) { const int rho = pp & 31; col = (pp & ~31) + 8 * ((rho & 15) >> 2) + 4 * (rho >> 4) + (rho & 3); }
    else if (mode == CM_POOL) col = (long)(pp >> 8) * 65536 + (pp & 255);
    else if (mode == CM_INC) { if (pp >= 1088) { zero = true; col = 0; } else if (pp >= 1024) { const int q = pp - 1024, w = q >> 5, t = q & 31; col = 1024 + 32 * ((t >> 2) & 1) + 16 * w + 4 * (t >> 3) + (t & 3); } }
    else if (mode == CM_UQ) { const int g64 = pp >> 6; if ((g64 % 3) == 2) { const int q = pp & 63, w = q >> 5, t = q & 31; col = g64 * 64 + 32 * ((t >> 2) & 1) + 16 * w + 4 * (t >> 3) + (t & 3); } }
    else if (mode == CM_UKVK) col = (pp >> 7) * 256 + (pp & 127);
    else if (mode == CM_UKVV) col = (pp >> 7) * 256 + 128 + (pp & 127);
    const float* sp = s + (size_t)k0 * ld + col; bf16_t* dp = dst + (size_t)CV_POS(lane >> 3) * K + k0 + (lane & 7) * 8;
    const size_t rstep = (size_t)8 * K, hstep = (size_t)(gu ? 128 : 32) * K;
    for (int kb = 0; kb < 256; kb += 64) {
        float v[64];
#pragma unroll
        for (int j = 0; j < 64; ++j) v[j] = zero ? 0.f : __builtin_nontemporal_load(sp + (size_t)(kb + j) * ld);
        if (gain) {
#pragma unroll
            for (int j = 0; j < 64; ++j) v[j] *= gain[k0 + kb + j];
        }
#pragma unroll
        for (int q = 0; q < 8; ++q) { u32x4 w; w.x = pk2(v[8 * q], v[8 * q + 1]); w.y = pk2(v[8 * q + 2], v[8 * q + 3]); w.z = pk2(v[8 * q + 4], v[8 * q + 5]); w.w = pk2(v[8 * q + 6], v[8 * q + 7]);
            *(LAS u32x4*)(wl + lane * 144 + q * 16) = w; }
        asm volatile("" ::: "memory");
#pragma unroll
        for (int j = 0; j < 8; ++j) { const u32x4 w = *(const LAS u32x4*)(wl + (8 * j + (lane >> 3)) * 144 + (lane & 7) * 16); *(u32x4*)(dp + (j & 3) * rstep + (j >> 2) * hstep + kb) = w; }
        asm volatile("" ::: "memory");
    }
#undef CV_POS
}

DI void phase0(CP& p, LAS unsigned char* lds, int wid) {
    const int lane = lane_id(), tid = wid * 64 + lane;
    constexpr int NCONV = 5520, NXROW = 8192;
    const int gw = blockIdx.x * 8 + wid, nw = gridDim.x * 8;
    for (int it0 = gw; it0 < NCONV + NXROW; it0 += nw) {
        const int it = it0 < NCONV ? NCONV - 1 - it0 : it0;
        if (it < NCONV) {
            const float* src; const float* src2 = nullptr; const float* gain = nullptr; bf16_t* dst; int ld, K, mode = CM_ID, coff = 0, t0;
            if (it < 256) { src = p.w_in_ab; gain = p.g_mix; dst = WSB(OFF_W1UZ); ld = 3072; K = 2048; mode = CM_UZ; t0 = 0; }
            else if (it < 384) { src = p.w_in_ab; gain = p.g_mix; dst = WSB(OFF_W1V); ld = 3072; K = 2048; coff = 1024; t0 = 256; }
            else if (it < 640) { src = p.w_out_ab; dst = WSB(OFF_WOAB); ld = 2048; K = 2048; mode = CM_P32; t0 = 384; }
            else if (it < 2048) { src = p.w_gate; src2 = p.w_up; gain = p.g_ffn; dst = WSB(OFF_WGU0); ld = DFF; K = 2048; mode = CM_GU; t0 = 640; }
            else if (it < 2752) { src = p.w_down; dst = WSB(OFF_WD0); ld = 2048; K = DFF; mode = CM_P32; t0 = 2048; }
            else if (it < 2768) { src = p.w_pool; dst = WSB(OFF_WPOOL); ld = 256; K = 256; mode = CM_POOL; t0 = 2752; }
            else if (it < 2928) { src = p.w_in_c; gain = p.g_mix + 2048; dst = WSB(OFF_WINC); ld = 1088; K = 2048; mode = CM_INC; t0 = 2768; }
            else if (it < 3024) { src = p.w_uq; gain = p.g_cq; dst = WSB(OFF_WUQ); ld = 3072; K = 512; mode = CM_UQ; t0 = 2928; }
            else if (it < 3088) { src = p.w_ukv; gain = p.g_ckv; dst = WSB(OFF_WUKK); ld = 4096; K = 512; mode = CM_UKVK; t0 = 3024; }
            else if (it < 3152) { src = p.w_ukv; gain = p.g_ckv; dst = WSB(OFF_WUKV); ld = 4096; K = 512; mode = CM_UKVV; t0 = 3088; }
            else if (it < 3408) { src = p.w_out_c; dst = WSB(OFF_WOC); ld = 2048; K = 2048; mode = CM_P32; t0 = 3152; }
            else if (it < 4816) { src = p.w_gate + (size_t)2048 * DFF; src2 = p.w_up + (size_t)2048 * DFF; gain = p.g_ffn + 2048; dst = WSB(OFF_WGU1); ld = DFF; K = 2048; mode = CM_GU; t0 = 3408; }
            else { src = p.w_down + (size_t)DFF * 2048; dst = WSB(OFF_WD1); ld = 2048; K = DFF; mode = CM_P32; t0 = 4816; }
            conv_item(lane, lds + wid * 9216, src, src2, gain, dst, ld, K, mode, coff, it - t0);
        } else {
            const int row = it - NCONV; const f32x4* xr = (const f32x4*)(p.x + (size_t)row * 2048); bf16_t* xb = WSB(OFF_XB) + (size_t)row * 2048;
            float ss = 0.f;
#pragma unroll
            for (int i = 0; i < 8; ++i) { const f32x4 v = __builtin_nontemporal_load(xr + i * 64 + lane); ss += v[0] * v[0] + v[1] * v[1] + v[2] * v[2] + v[3] * v[3]; *(u32x2*)(xb + (i * 64 + lane) * 4) = pk4(v); }
#pragma unroll
            for (int o = 1; o < 64; o <<= 1) ss += __shfl_xor(ss, o);
            if (lane == 0) SSQ(0)[row] = ss;
        }
    }
    const int gt = blockIdx.x * NTHR + tid, gs = gridDim.x * NTHR;
    for (int i = gt; i < 7 * 8192; i += gs) SSQ(1)[i] = 0.f;
    float* cs = WSF(OFF_CS);
    for (int i = gt; i < 4096 * 32; i += gs) { const int pos = i >> 5, j = i & 31;
        const float inv_freq = exp2f(-(float)j * (13.287712379549449f / 32.f)); const float ang = (float)pos * inv_freq;
        float sn, cn; sincosf(ang, &sn, &cn); cs[i] = cn; cs[4096 * 32 + i] = sn; }
}

DI void phase2(CP& p, LAS unsigned char* lds, int wid) {
    const int lane = lane_id(), tid = wid * 64 + lane, fr = lane & 15, fq = lane >> 4;
    const float* Z = WSF(OFF_Z); bf16_t* DP = WSB(OFF_DP);
    LAS unsigned char* wm = lds; LAS float* rsl = (LAS float*)(lds + 36864);
    for (int it = blockIdx.x; it < 256 + 512; it += gridDim.x) {
        if (it < 256) {
            const int gt = it * NTHR + tid, c = (gt & 255) * 4, run = gt >> 8, g = c >> 8, win = 2 << g;
            const int t0 = run * 16, tb = t0 & (SEQ - 1);
            f32x4 sum = {0.f, 0.f, 0.f, 0.f};
            for (int j = 1; j < win; ++j) if (tb - j >= 0) sum += *(const f32x4*)(Z + (size_t)(t0 - j) * 1024 + c);
            for (int i = 0; i < 16; ++i) { const int t = t0 + i, pos = tb + i; const f32x4 zc = *(const f32x4*)(Z + (size_t)t * 1024 + c);
                sum += zc; const float cnt = (float)((pos + 1) < win ? (pos + 1) : win); const f32x4 d = sum / cnt - zc;
                *(u32x2*)(DP + (size_t)t * 1024 + c) = pk4(d);
                if (pos - win + 1 >= 0) sum -= *(const f32x4*)(Z + (size_t)(t - win + 1) * 1024 + c); }
        } else {
            const int item = it - 256, nb = item >> 3, h = item & 7, t0 = nb * 128;
            if (tid < 128) rsl[tid] = rstd_of(SSQ(1)[t0 + tid], 1.f / 1024.f);
            __syncthreads();
            { const int t = tid >> 2, sq = (tid & 3) * 32; const float* wrow = p.w_s + ((size_t)h * 128 + t) * 128 + sq;
#pragma unroll
              for (int e = 0; e < 4; ++e) { const f32x4 a = *(const f32x4*)(wrow + e * 8), b = *(const f32x4*)(wrow + e * 8 + 4); const int s0 = sq + e * 8;
                  const float mk = ((s0 >> 6) <= (t >> 6)) ? 1.f : 0.f;
                  u32x4 w; w.x = pk2(a[0] * mk * rsl[s0], a[1] * mk * rsl[s0 + 1]); w.y = pk2(a[2] * mk * rsl[s0 + 2], a[3] * mk * rsl[s0 + 3]);
                  w.z = pk2(b[0] * mk * rsl[s0 + 4], b[1] * mk * rsl[s0 + 5]); w.w = pk2(b[2] * mk * rsl[s0 + 6], b[3] * mk * rsl[s0 + 7]);
                  *(LAS u32x4*)(wm + t * 272 + s0 * 2) = w; } }
            __syncthreads();
            const int ch = h * 128 + 16 * wid + fr; const bf16_t* vt = WSB(OFF_VT) + (size_t)ch * 8192 + t0 + 8 * fq;
            bf16x8 bfr[4];
#pragma unroll
            for (int ks = 0; ks < 4; ++ks) bfr[ks] = *(const bf16x8*)(vt + 32 * ks);
            f32x4 acc[8];
#pragma unroll
            for (int tt = 0; tt < 8; ++tt) { acc[tt] = (f32x4){0.f, 0.f, 0.f, 0.f};
#pragma unroll
                for (int ks = 0; ks < 4; ++ks) { const bf16x8 af = *(const LAS bf16x8*)(wm + (16 * tt + fr) * 272 + (32 * ks + 8 * fq) * 2);
                    acc[tt] = __builtin_amdgcn_mfma_f32_16x16x32_bf16(bfr[ks], af, acc[tt], 0, 0, 0); } }
            const int d0 = h * 128 + 16 * wid + 4 * fq; const f32x4 gv = *(const f32x4*)(p.g_v + d0);
#pragma unroll
            for (int tt = 0; tt < 8; ++tt) { const int t = 16 * tt + fr, tok = t0 + t; const float bs = p.b_s[h * 128 + t];
                const u32x2 uw = *(const u32x2*)(WSB(OFF_U) + (size_t)tok * 1024 + d0);
                f32x4 a; a[0] = bf_lo(uw.x) * (acc[tt][0] * gv[0] + bs); a[1] = bf_hi(uw.x) * (acc[tt][1] * gv[1] + bs);
                a[2] = bf_lo(uw.y) * (acc[tt][2] * gv[2] + bs); a[3] = bf_hi(uw.y) * (acc[tt][3] * gv[3] + bs);
                *(u32x2*)(WSB(OFF_CAT) + (size_t)tok * 2048 + d0) = pk4(a); }
            __syncthreads();
        }
    }
}

constexpr int KROW = 400, VROW = 136, KBYTES = 64 * KROW, ABUF = KBYTES + 128 * VROW;
DI void attn_unit(LAS unsigned char* lds, int wid, int b, int h, int qb) {
    CP& p = *kparams();
    const int lane = lane_id(), tid = wid * 64 + lane, n = lane & 31, g = lane >> 5;
    const int q0 = qb * 256 + wid * 32, cq = q0 >> 6, nkt = 4 * qb + 4;
    const size_t tokq = (size_t)b * SEQ + q0 + n;
    const bf16_t* Q = WSB(OFF_Q); const bf16_t* KN = WSB(OFF_KN); const bf16_t* KR = WSB(OFF_KR); const bf16_t* VT = WSB(OFF_VT2);
    bf16x8 qf[12];
#pragma unroll
    for (int ks = 0; ks < 12; ++ks) qf[ks] = *(const bf16x8*)(Q + tokq * 3072 + h * 192 + ks * 16 + g * 8);
    f32x16 o[4];
#pragma unroll
    for (int dt = 0; dt < 4; ++dt)
#pragma unroll
        for (int i = 0; i < 16; ++i) o[dt][i] = 0.f;
    float mrow = -__builtin_inff(), lrow = 0.f;
    const int krow = tid >> 4, kc16 = tid & 15, rrow = tid >> 3, rc8 = tid & 7;
    const bf16_t* kn_src = KN + ((size_t)b * SEQ + krow) * 2048 + h * 128 + kc16 * 8;
    const bf16_t* kr_src = KR + ((size_t)b * SEQ + rrow) * 64 + rc8 * 8;
    const bf16_t* v_src = VT + ((size_t)h * 128 + rrow) * 8192 + (size_t)b * SEQ + rc8 * 8;
    const int kn_dst = krow * KROW + kc16 * 16, kr_dst = rrow * KROW + 256 + rc8 * 16, v_dst = KBYTES + rrow * VROW + rc8 * 16;
    u32x4 st0, st1, st2, st3, st4;
#define A_LOAD(kt) do { const size_t ko = (size_t)(kt) * 64; st0 = *(const u32x4*)(kn_src + ko * 2048); st1 = *(const u32x4*)(kn_src + (ko + 32) * 2048); \
        st2 = *(const u32x4*)(kr_src + ko * 64); st3 = *(const u32x4*)(v_src + ko); st4 = *(const u32x4*)(v_src + ko + (size_t)64 * 8192); } while (0)
#define A_WRITE(buf) do { LAS unsigned char* bb = lds + (buf) * ABUF; *(LAS u32x4*)(bb + kn_dst) = st0; *(LAS u32x4*)(bb + kn_dst + 32 * KROW) = st1; *(LAS u32x4*)(bb + kr_dst) = st2; \
        *(LAS u32x2*)(bb + v_dst) = (u32x2){st3.x, st3.y}; *(LAS u32x2*)(bb + v_dst + 8) = (u32x2){st3.z, st3.w}; \
        *(LAS u32x2*)(bb + v_dst + 64 * VROW) = (u32x2){st4.x, st4.y}; *(LAS u32x2*)(bb + v_dst + 64 * VROW + 8) = (u32x2){st4.z, st4.w}; } while (0)
    A_LOAD(0); A_WRITE(0); __syncthreads();
    for (int kt = 0; kt < nkt; ++kt) {
        const int buf = kt & 1;
        if (kt + 1 < nkt) A_LOAD(kt + 1);
        if (kt <= cq) {
            LAS unsigned char* kb = lds + buf * ABUF; LAS unsigned char* vb = kb + KBYTES;
            f32x16 s0, s1;
#pragma unroll
            for (int i = 0; i < 16; ++i) { s0[i] = 0.f; s1[i] = 0.f; }
#define KLD(ks, h) (*(const LAS bf16x8*)(kb + (n + 32 * (h)) * KROW + (ks) * 32 + g * 16))
#define VLD(dst, j, dt) do { LAS unsigned char* va_ = vb + (32 * (dt) + n) * VROW + (16 * (j) + 4 * g) * 2; const u32x2 lo_ = *(const LAS u32x2*)(va_), hi_ = *(const LAS u32x2*)(va_ + 16); dst = (u32x4){lo_.x, lo_.y, hi_.x, hi_.y}; } while (0)
            bf16x8 ka[3][2];
            ka[0][0] = KLD(0, 0); ka[0][1] = KLD(0, 1); ka[1][0] = KLD(1, 0); ka[1][1] = KLD(1, 1);
#pragma unroll
            for (int ks = 0; ks < 12; ++ks) {
                if (ks + 2 < 12) { ka[(ks + 2) % 3][0] = KLD(ks + 2, 0); ka[(ks + 2) % 3][1] = KLD(ks + 2, 1); }
                s0 = __builtin_amdgcn_mfma_f32_32x32x16_bf16(ka[ks % 3][0], qf[ks], s0, 0, 0, 0); s1 = __builtin_amdgcn_mfma_f32_32x32x16_bf16(ka[ks % 3][1], qf[ks], s1, 0, 0, 0);
                __builtin_amdgcn_sched_barrier(0); }
            u32x4 vf[2][4];
#pragma unroll
            for (int dt = 0; dt < 4; ++dt) VLD(vf[0][dt], 0, dt);
            float mx = s0[0];
#pragma unroll
            for (int i = 1; i < 16; ++i) mx = fmaxf(mx, s0[i]);
#pragma unroll
            for (int i = 0; i < 16; ++i) mx = fmaxf(mx, s1[i]);
            mx = fmaxf(mx, shfl_xor_l(mx, lane, 32));
            const float mnew = fmaxf(mrow, mx), alpha = __builtin_amdgcn_exp2f(mrow - mnew); mrow = mnew;
            float ls = 0.f;
#pragma unroll
            for (int i = 0; i < 16; ++i) { s0[i] = __builtin_amdgcn_exp2f(s0[i] - mnew); s1[i] = __builtin_amdgcn_exp2f(s1[i] - mnew); ls += s0[i] + s1[i]; }
            lrow = lrow * alpha + ls;
            if (__builtin_amdgcn_ballot_w64(alpha != 1.f) != 0ull) {
#pragma unroll
                for (int dt = 0; dt < 4; ++dt)
#pragma unroll
                    for (int i = 0; i < 16; ++i) o[dt][i] *= alpha;
            }
            bf16x8 pf[4];
#pragma unroll
            for (int jj = 0; jj < 2; ++jj) { u32x4 w0, w1;
                w0.x = pk2(s0[8 * jj + 0], s0[8 * jj + 1]); w0.y = pk2(s0[8 * jj + 2], s0[8 * jj + 3]); w0.z = pk2(s0[8 * jj + 4], s0[8 * jj + 5]); w0.w = pk2(s0[8 * jj + 6], s0[8 * jj + 7]);
                w1.x = pk2(s1[8 * jj + 0], s1[8 * jj + 1]); w1.y = pk2(s1[8 * jj + 2], s1[8 * jj + 3]); w1.z = pk2(s1[8 * jj + 4], s1[8 * jj + 5]); w1.w = pk2(s1[8 * jj + 6], s1[8 * jj + 7]);
                pf[jj] = __builtin_bit_cast(bf16x8, w0); pf[2 + jj] = __builtin_bit_cast(bf16x8, w1); }
#pragma unroll
            for (int j = 0; j < 4; ++j) {
                if (j < 3) {
#pragma unroll
                    for (int dt = 0; dt < 4; ++dt) VLD(vf[(j + 1) & 1][dt], j + 1, dt);
                }
#pragma unroll
                for (int dt = 0; dt < 4; ++dt) o[dt] = __builtin_amdgcn_mfma_f32_32x32x16_bf16(__builtin_bit_cast(bf16x8, vf[j & 1][dt]), pf[j], o[dt], 0, 0, 0);
                __builtin_amdgcn_sched_barrier(0); }
#undef KLD
#undef VLD
        }
        if (kt + 1 < nkt) A_WRITE(buf ^ 1);
        __syncthreads();
    }
#undef A_LOAD
#undef A_WRITE
    const float lt = lrow + shfl_xor_l(lrow, lane, 32), inv = 1.f / lt;
    LAS unsigned char* pt_ = lds + ABUF + wid * (32 * 272);
#pragma unroll
    for (int dt = 0; dt < 4; ++dt)
#pragma unroll
        for (int blk = 0; blk < 4; ++blk) { const f32x4 v = {o[dt][4 * blk] * inv, o[dt][4 * blk + 1] * inv, o[dt][4 * blk + 2] * inv, o[dt][4 * blk + 3] * inv};
            *(LAS u32x2*)(pt_ + n * 272 + (32 * dt + 8 * blk + 4 * g) * 2) = pk4(v); }
    asm volatile("" ::: "memory");
    bf16_t* od = WSB(OFF_O) + ((size_t)b * SEQ + q0 + (lane >> 4)) * 2048 + h * 128 + (lane & 15) * 8;
#pragma unroll
    for (int j = 0; j < 8; ++j) { const u32x4 w = *(const LAS u32x4*)(pt_ + (4 * j + (lane >> 4)) * 272 + (lane & 15) * 16); *(u32x4*)(od + (size_t)(4 * j) * 2048) = w; }
    asm volatile("" ::: "memory");
}
DI void phase_attn(CP& p, LAS unsigned char* lds, int wid) {
    for (int P = blockIdx.x; P < 256; P += gridDim.x) {
        const int xcd = P & 7, idx = P >> 3, bh = xcd * 4 + (idx >> 3), x = idx & 7, b = bh >> 4, h = bh & 15;
        attn_unit(lds, wid, b, h, 15 - x);
        attn_unit(lds, wid, b, h, x);
    }
}

DI void phase_final(CP& p, int wid) {
    const int lane = lane_id();
    for (int it = blockIdx.x; it < 1024; it += gridDim.x) {
        const int row = it * 8 + wid; const float rs = rstd_of(SSQ(7)[row], 1.f / 2048.f);
        const u32x4* xr = (const u32x4*)(WSB(OFF_XB) + (size_t)row * 2048); f32x4* orow = (f32x4*)(p.out + (size_t)row * 2048); const f32x4* gf = (const f32x4*)p.g_final;
#pragma unroll
        for (int i = 0; i < 4; ++i) { const u32x4 w = xr[i * 64 + lane]; const int c = (i * 64 + lane) * 2;
            const f32x4 a = {bf_lo(w.x), bf_hi(w.x), bf_lo(w.y), bf_hi(w.y)}, b = {bf_lo(w.z), bf_hi(w.z), bf_lo(w.w), bf_hi(w.w)};
            orow[c] = a * rs * gf[c]; orow[c + 1] = b * rs * gf[c + 1]; }
    }
}

#define XB_TMO      128
#define XB_XCNT(j)  (256  + 64 * (j))
#define XB_XSUB(j)  (1280 + 64 * (j))
#define XB_XGEN(j)  (2304 + 64 * (j))
#define XB_TOP      3328
#define XB_TOPGEN   3392
#define XCD_BAR_WORDS 3456
#define XB_SPIN_CAP (1u << 22)
DI unsigned xb_ld(unsigned* q) { return __hip_atomic_load(q, __ATOMIC_RELAXED, __HIP_MEMORY_SCOPE_AGENT); }
DI unsigned xb_add(unsigned* q, unsigned v) { return __hip_atomic_fetch_add(q, v, __ATOMIC_RELAXED, __HIP_MEMORY_SCOPE_AGENT); }
DI unsigned xb_xcc_id() { return (unsigned)__builtin_amdgcn_s_getreg((3 << 11) | 20) & 0xFu; }
#define XB_SPIN(cond, bar) do { unsigned _sp = 0; while (cond) { __builtin_amdgcn_s_sleep(1); \
    if ((++_sp & 255u) == 0u) { if (xb_ld(&(bar)[XB_TMO])) break; if (_sp > XB_SPIN_CAP) { atomicAdd(&(bar)[XB_TMO], 1u); break; } } } } while (0)
DI void xcd_barrier_complete(unsigned* bar, unsigned x, unsigned& nloc, unsigned& nx) {
    const unsigned G = gridDim.x;
    unsigned sum, cnt, mine, sp = 0u;
    for (;;) {
        sum = 0u; cnt = 0u; mine = 0u;
#pragma unroll
        for (unsigned j = 0; j < 16; ++j) { const unsigned c = xb_ld(&bar[XB_XCNT(j)]); sum += c; cnt += (c > 0u) ? 1u : 0u; mine = (j == x) ? c : mine; }
        if (sum == G) break;
        __builtin_amdgcn_s_sleep(1);
        if ((++sp & 255u) == 0u) { if (xb_ld(&bar[XB_TMO])) break; if (sp > XB_SPIN_CAP) { atomicAdd(&bar[XB_TMO], 1u); break; } }
    }
    nloc = mine > 0u ? mine : 1u; nx = cnt > 0u ? cnt : 1u;
}
DI void grid_bar(unsigned* bar, volatile LAS unsigned* st, int wid) {
    asm volatile("s_waitcnt vmcnt(0)" ::: "memory");
    __syncthreads();
    if (wid == 0) {
        if (lane_id() == 0) {
            __builtin_amdgcn_s_waitcnt(0);
            const unsigned x = xb_xcc_id();
            unsigned nloc = st[0], nx = st[1];
            if (nloc == 0u) { xcd_barrier_complete(bar, x, nloc, nx); st[0] = nloc; st[1] = nx; }
            const unsigned old = xb_add(&bar[XB_XSUB(x)], 1u);
            const unsigned gen = old / nloc;
            if (old + 1u == (gen + 1u) * nloc) {
                __builtin_amdgcn_fence(__ATOMIC_RELEASE, "agent");
                asm volatile("s_waitcnt vmcnt(0)" ::: "memory");
                const unsigned og = xb_add(&bar[XB_TOP], 1u);
                const unsigned tg = og / nx;
                if (og + 1u == (tg + 1u) * nx) xb_add(&bar[XB_TOPGEN], 1u);
                else XB_SPIN(xb_ld(&bar[XB_TOPGEN]) == tg, bar);
                __builtin_amdgcn_fence(__ATOMIC_ACQUIRE, "agent");
                xb_add(&bar[XB_XGEN(x)], 1u);
                asm volatile("s_waitcnt vmcnt(0)" ::: "memory");
            } else {
                XB_SPIN(xb_ld(&bar[XB_XGEN(x)]) == gen, bar);
                __builtin_amdgcn_fence(__ATOMIC_ACQUIRE, "agent");
                asm volatile("s_waitcnt vmcnt(0)" ::: "memory");
            }
        }
    }
    __syncthreads();
}

__global__ void __launch_bounds__(NTHR, 2) mega(Params pv) {
    extern __shared__ __attribute__((aligned(16))) unsigned char lds_raw[];
    LAS unsigned char* lds = (LAS unsigned char*)lds_raw;
    cg::grid_group grid = cg::this_grid();
    const int wid = __builtin_amdgcn_readfirstlane((int)threadIdx.x >> 6);
    const int ph_lo = pv.ph_lo, ph_hi = pv.ph_hi;
    if (ph_lo == 0x7fffffff) grid.sync();
    if (ph_hi - ph_lo > 1) {
        if (wid == 0 && lane_id() == 0) { volatile LAS unsigned* st = (volatile LAS unsigned*)(lds + LDS_MAIN); st[0] = 0u; st[1] = 0u;
            CP& p0 = *kparams(); (void)xb_add(&((unsigned*)(p0.ws + OFF_BAR))[XB_XCNT(xb_xcc_id())], 1u); }
        __syncthreads();
    }
    const bool probe_dry = PROBE_FULL ? false : (ph_hi == NPH); const int probe_sqo = (ph_hi == NPH) ? 8 : 0;
#ifdef ONLY_PH
#define IN(k) ((k) == ONLY_PH && ph_lo <= (k) && (k) < ph_hi)
#else
#define IN(k) (ph_lo <= (k) && (k) < ph_hi)
#endif
#define GP CP& p = *kparams()
#define RUNG(k, ...) do { if (PROBE_PH == (k)) run_gemm<k>(p, lds, wid, probe_dry, probe_sqo, __VA_ARGS__); run_gemm<k>(p, lds, wid, false, 0, __VA_ARGS__); } while (0)
#define SEAM(k) do { if (IN(k) && IN((k) + 1)) { GP; grid_bar((unsigned*)(p.ws + OFF_BAR), (volatile LAS unsigned*)(lds + LDS_MAIN), wid); if (PROBE_BAR) grid_bar((unsigned*)(p.ws + OFF_BAR), (volatile LAS unsigned*)(lds + LDS_MAIN), wid); } } while (0)
    if (IN(0)) { GP; if (PROBE_PH == 0) phase0(p, lds, wid); phase0(p, lds, wid); }
    SEAM(0);
    if (IN(1)) { GP; const Sub a = mk_sub(WSB(OFF_XB), WSB(OFF_W1UZ), MT, 2048, 2048, 2048, K_UZ), b = mk_sub(WSB(OFF_W1V), WSB(OFF_XB), 1024, MT, 2048, 2048, K_VT);
        RUNG(1, 2048, 2048, 2048, a, &b, nullptr); }
    SEAM(1);
    if (IN(2)) { GP; if (PROBE_PH == 2) phase2(p, lds, wid); phase2(p, lds, wid); }
    SEAM(2);
    if (IN(3)) { GP; const Sub a = mk_sub(WSB(OFF_DP), WSB(OFF_WPOOL), MT, 1024, 1024, 256, K_POOL, 512); RUNG(3, 256, 1024, 256, a, nullptr, nullptr); }
    SEAM(3);
    if (IN(4)) { GP; const Sub a = mk_sub(WSB(OFF_CAT), WSB(OFF_WOAB), MT, 2048, 2048, 2048, K_RES); RUNG(4, 2048, 2048, 2048, a, nullptr, nullptr); }
    SEAM(4);
    if (IN(5)) { GP; const Sub a = mk_sub(WSB(OFF_XB), WSB(OFF_WGU0), MT, 2 * DFF, 2048, 2048, K_SWIGLU); RUNG(5, 2048, 2048, 2048, a, nullptr, nullptr); }
    SEAM(5);
    if (IN(6)) { GP; const Sub a = mk_sub(WSB(OFF_ACT), WSB(OFF_WD0), MT, 2048, DFF, DFF, K_RES); RUNG(6, DFF, DFF, DFF, a, nullptr, nullptr); }
    SEAM(6);
    if (IN(7)) { GP; const Sub a = mk_sub(WSB(OFF_XB), WSB(OFF_WINC), MT, 1280, 2048, 2048, K_INC); RUNG(7, 2048, 2048, 2048, a, nullptr, nullptr); }
    SEAM(7);
    if (IN(8)) { GP; const Sub a = mk_sub(WSB(OFF_CQ), WSB(OFF_WUQ), MT, 3072, 512, 512, K_Q), b = mk_sub(WSB(OFF_CKV), WSB(OFF_WUKK), MT, 2048, 512, 512, K_KN),
                           c = mk_sub(WSB(OFF_WUKV), WSB(OFF_CKV), 2048, MT, 512, 512, K_VT2);
        RUNG(8, 512, 512, 512, a, &b, &c); }
    SEAM(8);
    if (IN(9)) { GP; if (PROBE_PH == 9) phase_attn(p, lds, wid); phase_attn(p, lds, wid); }
    SEAM(9);
    if (IN(10)) { GP; const Sub a = mk_sub(WSB(OFF_O), WSB(OFF_WOC), MT, 2048, 2048, 2048, K_RES); RUNG(10, 2048, 2048, 2048, a, nullptr, nullptr); }
    SEAM(10);
    if (IN(11)) { GP; const Sub a = mk_sub(WSB(OFF_XB), WSB(OFF_WGU1), MT, 2 * DFF, 2048, 2048, K_SWIGLU); RUNG(11, 2048, 2048, 2048, a, nullptr, nullptr); }
    SEAM(11);
    if (IN(12)) { GP; const Sub a = mk_sub(WSB(OFF_ACT), WSB(OFF_WD1), MT, 2048, DFF, DFF, K_RES); RUNG(12, DFF, DFF, DFF, a, nullptr, nullptr); }
    SEAM(12);
    if (IN(13)) { GP; phase_final(p, wid); }
}

extern "C" void kernel_launch(void* const* d_in, const int* in_sizes, int n_in, void* d_out, int out_size, void* d_ws, size_t ws_size, hipStream_t stream) {
    static int grid = 0;
    if (grid == 0) {
        if (n_in != 20 || ws_size < WS_NEED) { fprintf(stderr, "kernel_launch: unexpected n_in %d / ws_size %zu (need %zu)\n", n_in, ws_size, (size_t)WS_NEED); grid = -1; return; }
        int dev = 0, cus = 0, per = 0;
        (void)hipGetDevice(&dev); (void)hipDeviceGetAttribute(&cus, hipDeviceAttributeMultiprocessorCount, dev);
        if (hipFuncSetAttribute((const void*)mega, hipFuncAttributeMaxDynamicSharedMemorySize, LDS_BYTES) != hipSuccess) fprintf(stderr, "kernel_launch: hipFuncSetAttribute failed\n");
        if (hipOccupancyMaxActiveBlocksPerMultiprocessor(&per, (const void*)mega, NTHR, LDS_BYTES) != hipSuccess || per < 1) { fprintf(stderr, "kernel_launch: occupancy query gave %d\n", per); per = 1; }
        (void)hipGetLastError();
        grid = cus * per;
        fprintf(stderr, "kernel_launch: grid %d (cus %d x %d)\n", grid, cus, per);
    }
    if (grid < 0) return;
    Params p{};
    p.x = (const float*)d_in[0]; p.g_mix = (const float*)d_in[1]; p.g_ffn = (const float*)d_in[2]; p.g_final = (const float*)d_in[3]; p.w_in_ab = (const float*)d_in[4];
    p.g_v = (const float*)d_in[5]; p.w_s = (const float*)d_in[6]; p.b_s = (const float*)d_in[7]; p.w_pool = (const float*)d_in[8]; p.pool_scale = (const float*)d_in[9];
    p.w_out_ab = (const float*)d_in[10]; p.w_in_c = (const float*)d_in[11]; p.g_cq = (const float*)d_in[12]; p.g_ckv = (const float*)d_in[13]; p.w_uq = (const float*)d_in[14];
    p.w_ukv = (const float*)d_in[15]; p.w_out_c = (const float*)d_in[16]; p.w_gate = (const float*)d_in[17]; p.w_up = (const float*)d_in[18]; p.w_down = (const float*)d_in[19];
    p.out = (float*)d_out; p.ws = (unsigned char*)d_ws;
#if MEGA
    (void)hipMemsetAsync((char*)d_ws + OFF_BAR, 0, XCD_BAR_WORDS * 4, stream);
    p.ph_lo = 0; p.ph_hi = NPH;
    void* args[] = {&p};
    hipError_t e = hipLaunchCooperativeKernel((const void*)mega, dim3(grid), dim3(NTHR), args, LDS_BYTES, stream);
    if (e != hipSuccess) fprintf(stderr, "kernel_launch: cooperative launch failed: %s (grid %d)\n", hipGetErrorString(e), grid);
#else
    for (int k = 0; k < NPH; ++k) { p.ph_lo = k; p.ph_hi = k + 1; hipLaunchKernelGGL(mega, dim3(grid), dim3(NTHR), LDS_BYTES, stream, p); }
#endif
}
```
